# Optimizing an MI355X kernel written in HIP

```python
import math
import jax, jax.numpy as jnp
from jax import lax
import numpy as np

D_MODEL = 4096
BATCH = 2
SEQ = 8192
DEPTH = 2

N_A_LAYERS = DEPTH // 2
N_B_LAYERS = DEPTH - N_A_LAYERS
RET_HEADS = 16
RET_HEAD_DIM = D_MODEL // RET_HEADS
RET_CHUNK = 128
RET_DECAY_BASE = 5.0
ROPE_BASE = 10000.0
DIFF_HEADS = 16
DIFF_HEAD_DIM = D_MODEL // DIFF_HEADS // 2
DIFF_Q_BLOCK = 128
FFN_HIDDEN = ((8 * D_MODEL + 767) // 768) * 256
NORM_EPS = 1e-6
HEAD_NORM_EPS = 1e-5

kernel_name = 'yoco_retention_diffattn_sandwich'


def rms_norm(x, g, eps=NORM_EPS):
    xf = x.astype(jnp.float32)
    y = xf * lax.rsqrt(jnp.mean(xf * xf, axis=-1, keepdims=True) + eps)
    return (y * g.astype(jnp.float32)).astype(x.dtype)


def rotary(t):
    s, dh = t.shape[1], t.shape[-1]
    inv_freq = 1.0 / (ROPE_BASE ** jnp.linspace(0.0, 1.0, dh // 2, dtype=jnp.float32))
    ang = jnp.arange(s, dtype=jnp.float32)[:, None] * inv_freq[None, :]
    cos, sin = jnp.cos(ang)[:, None, :], jnp.sin(ang)[:, None, :]
    t1, t2 = t[..., 0::2], t[..., 1::2]
    return jnp.stack([t1 * cos - t2 * sin, t1 * sin + t2 * cos], axis=-1).reshape(t.shape)


def retention(xn, w_in, w_out):
    b, s, d = xn.shape
    H, dh, L = RET_HEADS, RET_HEAD_DIM, RET_CHUNK
    nc = s // L
    f32 = jnp.float32
    q, k, v, g = jnp.split(xn @ w_in, 4, axis=-1)
    q = rotary(q.astype(f32).reshape(b, s, H, dh))
    k = rotary(k.astype(f32).reshape(b, s, H, dh)) * (dh ** -0.5)
    v = v.astype(f32).reshape(b, s, H, dh)

    log_g = jnp.log1p(-jnp.exp2(-RET_DECAY_BASE - jnp.arange(H, dtype=f32)))
    n = jnp.arange(L, dtype=f32)
    rel = n[:, None] - n[None, :]
    intra = jnp.where(rel >= 0, jnp.exp(log_g[:, None, None] * rel), 0.0)
    q_decay = jnp.exp(log_g[:, None] * (n + 1.0))
    k_decay = jnp.exp(log_g[:, None] * (L - 1.0 - n))
    chunk_decay = jnp.exp(log_g * L)

    def to_chunks(t):
        return t.reshape(b, nc, L, H, dh).transpose(1, 0, 3, 2, 4)

    def step(state, inp):
        qc, kc, vc = inp
        scores = jnp.einsum('bhnk,bhmk->bhnm', qc, kc) * intra
        out = (jnp.einsum('bhnm,bhmv->bhnv', scores, vc)
               + jnp.einsum('bhnk,bhkv->bhnv', qc * q_decay[:, :, None], state))
        state = (state * chunk_decay[:, None, None]
                 + jnp.einsum('bhmk,bhmv->bhkv', kc * k_decay[:, :, None], vc))
        return state, out

    state0 = jnp.zeros((b, H, dh, dh), f32)
    _, o = lax.scan(step, state0, (to_chunks(q), to_chunks(k), to_chunks(v)))
    o = o.transpose(1, 0, 3, 2, 4).reshape(b, s, H, dh)
    mu = jnp.mean(o, axis=-1, keepdims=True)
    var = jnp.mean(jnp.square(o - mu), axis=-1, keepdims=True)
    o = (o - mu) * lax.rsqrt(var + HEAD_NORM_EPS)
    o = o.reshape(b, s, d) * jax.nn.silu(g.astype(f32))
    return o.astype(xn.dtype) @ w_out


def shared_kv(h, kv_norm_g, kv_w):
    b, s, d = h.shape
    kv = (rms_norm(h, kv_norm_g) @ kv_w).astype(jnp.float32)
    k, v = jnp.split(kv, 2, axis=-1)
    k = k.reshape(b, s, DIFF_HEADS, 2, DIFF_HEAD_DIM).transpose(0, 2, 3, 1, 4)
    v = v.reshape(b, s, DIFF_HEADS, 2 * DIFF_HEAD_DIM).transpose(0, 2, 1, 3)
    return k, v


def diff_attention(xn, k_sh, v_sh, w_q, lam_params, subln_g, w_out, lambda_init):
    b, s, d = xn.shape
    H, dh, QB = DIFF_HEADS, DIFF_HEAD_DIM, DIFF_Q_BLOCK
    nq = s // QB
    f32 = jnp.float32
    q = (xn @ w_q).astype(f32) * (dh ** -0.5)
    q = q.reshape(b, nq, QB, H, 2, dh).transpose(1, 0, 3, 4, 2, 5)
    lp = lam_params.astype(f32)
    lam = jnp.exp(jnp.sum(lp[0] * lp[1])) - jnp.exp(jnp.sum(lp[2] * lp[3])) + lambda_init
    key_pos = jnp.arange(s)

    def block(args):
        qb, i = args
        scores = jnp.einsum('bhiqd,bhikd->bhiqk', qb, k_sh)
        q_pos = i * QB + jnp.arange(QB)
        causal = key_pos[None, :] <= q_pos[:, None]
        p = jax.nn.softmax(jnp.where(causal, scores, -jnp.inf), axis=-1)
        a = p[:, :, 0] - lam * p[:, :, 1]
        return jnp.einsum('bhqk,bhkv->bhqv', a, v_sh)

    o = lax.map(block, (q, jnp.arange(nq)))
    o = o.transpose(1, 0, 3, 2, 4).reshape(b, s, H, 2 * dh)
    o = rms_norm(o, subln_g, HEAD_NORM_EPS) * (1.0 - lambda_init)
    return o.reshape(b, s, d).astype(xn.dtype) @ w_out


def swiglu(xn, w_gate_up, w_down):
    gate, up = jnp.split(xn @ w_gate_up, 2, axis=-1)
    return (jax.nn.silu(gate) * up) @ w_down


def setup_inputs(seed: int = 0) -> dict:
    key = jax.random.key(seed)
    ks = jax.random.split(key, 20)
    D, F = D_MODEL, FFN_HIDDEN
    nA, nB = N_A_LAYERS, N_B_LAYERS

    def w(k, shape, fan_in):
        return jax.random.normal(k, shape, jnp.float32) * (fan_in ** -0.5)

    def gain(k, shape):
        return 1.0 + 0.02 * jax.random.normal(k, shape, jnp.float32)

    return {
        'x': jax.random.normal(ks[0], (BATCH, SEQ, D), jnp.float32),
        'ret_norm_pre': gain(ks[1], (nA, D)),
        'ret_norm_post': gain(ks[2], (nA, D)),
        'ret_w_in': w(ks[3], (nA, D, 4 * D), D),
        'ret_w_out': w(ks[4], (nA, D, D), D),
        'kv_norm': gain(ks[5], (D,)),
        'kv_w': w(ks[6], (D, 2 * D), D),
        'dif_norm_pre': gain(ks[7], (nB, D)),
        'dif_norm_post': gain(ks[8], (nB, D)),
        'dif_w_q': w(ks[9], (nB, D, D), D),
        'dif_lambda': 0.1 * jax.random.normal(ks[10], (nB, 4, DIFF_HEAD_DIM), jnp.float32),
        'dif_subln': gain(ks[11], (nB, 2 * DIFF_HEAD_DIM)),
        'dif_w_out': w(ks[12], (nB, D, D), D),
        'ffn_norm_pre': gain(ks[13], (DEPTH, D)),
        'ffn_norm_post': gain(ks[14], (DEPTH, D)),
        'ffn_w_gate_up': w(ks[15], (DEPTH, D, 2 * F), D),
        'ffn_w_down': w(ks[16], (DEPTH, F, D), F),
    }


def reference(x, ret_norm_pre, ret_norm_post, ret_w_in, ret_w_out, kv_norm, kv_w,
              dif_norm_pre, dif_norm_post, dif_w_q, dif_lambda, dif_subln, dif_w_out,
              ffn_norm_pre, ffn_norm_post, ffn_w_gate_up, ffn_w_down):
    h = x
    k_sh = v_sh = None
    for l in range(DEPTH):
        if l < N_A_LAYERS:
            a = l
            mix = retention(rms_norm(h, ret_norm_pre[a]), ret_w_in[a], ret_w_out[a])
            h = h + rms_norm(mix, ret_norm_post[a])
        else:
            bl = l - N_A_LAYERS
            if l == N_A_LAYERS:
                k_sh, v_sh = shared_kv(h, kv_norm, kv_w)
            lambda_init = 0.8 - 0.6 * math.exp(-0.3 * l)
            mix = diff_attention(rms_norm(h, dif_norm_pre[bl]), k_sh, v_sh, dif_w_q[bl],
                                 dif_lambda[bl], dif_subln[bl], dif_w_out[bl], lambda_init)
            h = h + rms_norm(mix, dif_norm_post[bl])
        ffn = swiglu(rms_norm(h, ffn_norm_pre[l]), ffn_w_gate_up[l], ffn_w_down[l])
        h = h + rms_norm(ffn, ffn_norm_post[l])
    return h
```

```cpp
#include <hip/hip_runtime.h>
#include <cstdio>
#include <cstdint>
#include <cmath>
#define MK_STWT16(p, v, wt) do { if (wt) asm volatile("global_store_dwordx4 %0, %1, off sc1\n\ts_nop 1" :: "v"(p), "v"(v) : "memory"); else *(p) = (v); } while (0)
#define MK_STWT8(p, v, wt) do { if (wt) asm volatile("global_store_dwordx2 %0, %1, off sc1\n\ts_nop 1" :: "v"(p), "v"(v) : "memory"); else *(p) = (v); } while (0)
#ifndef MK_BTILED
#define MK_BTILED 1
#endif
#ifndef MK_HTILED
#define MK_HTILED 0
#endif
#ifndef MK_FRESH
#define MK_FRESH 1
#endif
#ifndef MK_PN_ROT
#define MK_PN_ROT 0
#endif
__device__ __forceinline__ int mk_lane() { int l; asm volatile("v_mbcnt_lo_u32_b32 %0, -1, 0\n\tv_mbcnt_hi_u32_b32 %0, -1, %0" : "=v"(l)); return l; }
namespace pg8 {
#define PG8_LAS __attribute__((address_space(3)))
typedef unsigned short bf16_t;
typedef short bf16x8 __attribute__((ext_vector_type(8)));
typedef float f32x4 __attribute__((ext_vector_type(4)));
typedef unsigned u32x4 __attribute__((ext_vector_type(4)));
constexpr int BM = 256, BK = 64, HALF = 128, HTB = HALF * BK * 2  , STAGE_BYTES = 8 * HTB, NXCD = 8, WGM = 8;

__host__ __device__ __forceinline__ int lds_byte(int r, int c) { const int st = (r >> 4) * 2 + (c >> 5), rr = r & 15, cc = c & 31, ob = rr * 64 + cc * 2; return st * 1024 + (ob ^ (((ob >> 9) & 1) << 5)); }
__host__ __device__ __forceinline__ void stage_rc(int b, int& R, int& C) { const int st = b / 1024, sb = b % 1024, swz = sb ^ (((sb >> 9) & 1) << 5); R = (st >> 1) * 16 + swz / 64; C = (st & 1) * 32 + (swz % 64) / 2; }
__host__ __device__ __forceinline__ int perm32(int rho) { const int n = rho >> 4, i = rho & 15; return 8 * (i >> 2) + 4 * n + (i & 3); }

struct Unit { int pm, pn; };
struct Gemm { const bf16_t* A; const bf16_t* Bt; int M, N, K; };

struct StaticOrder {
    int nM, nN, nwg, G, c, pm0;
    __host__ __device__ void init(int M, int N, int G_, int c_, int pm0_ = 0) { nM = M / BM; nN = N / BM; nwg = nM * nN; G = G_; c = c_; pm0 = pm0_; }
    __host__ __device__ bool next(int i, Unit& u) const {
        const long L = (long)i * G + c; if (L >= nwg) return false;
        int wgid = (int)L; { const int q = nwg / NXCD, r = nwg % NXCD, xcd = wgid % NXCD, off = wgid / NXCD; wgid = (xcd < r ? xcd * (q + 1) : r * (q + 1) + (xcd - r) * q) + off; }
        const int nig = WGM * nN, gid = wgid / nig, fm = gid * WGM, gsz = (nM - fm) < WGM ? (nM - fm) : WGM;
        u.pm = pm0 + fm + ((wgid % nig) % gsz); u.pn = (wgid % nig) / gsz;
#if MK_PN_ROT
        { int p = u.pn + (c & 7) * (nN / 8); u.pn = p >= nN ? p - nN : p; }
#endif
        return true;
    }
    __device__ __forceinline__ void a_ready(const Unit&) const {}
    __device__ __forceinline__ void done(const Unit&) const {}
};

struct NStatOrder {
    int nM, nN, G, c;
    __host__ __device__ void init(int M, int N, int G_, int c_) { nM = M / BM; nN = N / BM; G = G_; c = c_; }
    __host__ __device__ bool next(int i, Unit& u) const {
        const int x = c & 7, cc = c >> 3, per = nN >> 3, rpb = nM >> 3, nb = per >> 2;
        if (i >= nb * rpb || cc >= 32) return false;
        const int hb = i / rpb, pmb = i - hb * rpb;
        u.pm = 8 * pmb + (cc & 7); u.pn = x * per + 4 * hb + (cc >> 3); return true;
    }
    __device__ __forceinline__ void a_ready(const Unit&) const {}
    __device__ __forceinline__ void done(const Unit&) const {}
};

__device__ __forceinline__ unsigned cvt_pk_bf16(float lo, float hi) { unsigned r; asm volatile("v_cvt_pk_bf16_f32 %0, %1, %2" : "=v"(r) : "v"(lo), "v"(hi)); return r; }
typedef float f32x2 __attribute__((ext_vector_type(2)));
#ifndef MK_P1_FRESH
#define MK_P1_FRESH 1
#endif
#ifndef MK_NT_STORES
#define MK_NT_STORES 0
#endif
#if MK_NT_STORES
#define PG8_ST16(p, v) __builtin_nontemporal_store((v), (u32x4*)(p))
#else
#ifndef MK_LAST_WT
#define MK_LAST_WT 1
#endif
#define PG8_ST16(p, v) do { if (MK_LAST_WT && wt) asm volatile("global_store_dwordx4 %0, %1, off sc1\n\ts_nop 1" :: "v"((u32x4*)(p)), "v"(v) : "memory"); else *(u32x4*)(p) = (v); } while (0)
#endif
__device__ __forceinline__ float silu_f(float v) { return v * __builtin_amdgcn_rcpf(1.0f + __builtin_amdgcn_exp2f(-1.4426950408889634f * v)); }
struct EpiQKVG {
    static constexpr bool PERM = true, AFTER_DRAIN = false; static constexpr bool RS_LDS = false; static constexpr int NST = 16; static constexpr bool FRESH_OK = MK_P1_FRESH != 0;
    bf16_t* O;
    __device__ __forceinline__ void operator()(const f32x4 (&acc)[2][2][4][2], const Unit& u, int wr, int wc, int fr, int fq, const PG8_LAS float* rsl, int wt) const {
        asm volatile("" : "+v"(fr), "+v"(fq));
        const int row0 = u.pm * BM + wr * 64 + fr, t = u.pn >> 4, colt = (u.pn & 15) * BM;
        bf16_t* base = O + (size_t)t * ((size_t)16384 * 4096);
        const int col0 = colt + wc * 32 + 8 * fq;
        float ivf[2][4];
#pragma unroll
        for (int bj = 0; bj < 2; ++bj)
#pragma unroll
            for (int j = 0; j < 4; ++j) ivf[bj][j] = __builtin_amdgcn_exp2f((float)(64 * bj + 16 * wc + 4 * fq + j) * (-13.287712379549449f / 127.0f));
#pragma unroll
        for (int ai = 0; ai < 2; ++ai)
#pragma unroll
            for (int m = 0; m < 4; ++m) { const int row = row0 + ai * HALF + m * 16, pos = row & 8191; bf16_t* rowp = base + (size_t)row * 4096 + col0;
#pragma unroll
                for (int bj = 0; bj < 2; ++bj) { f32x4 v0 = acc[ai][bj][m][0], v1 = acc[ai][bj][m][1];
                    if (t < 2) { f32x4 c, s;
#pragma unroll
                        for (int j = 0; j < 4; ++j) { const float ang = (float)pos * ivf[bj][j], rev = ang * 0.15915494309189535f, frc = __builtin_amdgcn_fractf(rev); c[j] = __builtin_amdgcn_cosf(frc); s[j] = __builtin_amdgcn_sinf(frc); }
                        const float sc = (t == 1) ? 0.0625f : 1.0f;
                        f32x4 r0, r1;
                        r0[0] = (v0[0] * c[0] - v0[1] * s[0]) * sc; r0[1] = (v0[0] * s[0] + v0[1] * c[0]) * sc;
                        r0[2] = (v0[2] * c[1] - v0[3] * s[1]) * sc; r0[3] = (v0[2] * s[1] + v0[3] * c[1]) * sc;
                        r1[0] = (v1[0] * c[2] - v1[1] * s[2]) * sc; r1[1] = (v1[0] * s[2] + v1[1] * c[2]) * sc;
                        r1[2] = (v1[2] * c[3] - v1[3] * s[3]) * sc; r1[3] = (v1[2] * s[3] + v1[3] * c[3]) * sc;
                        v0 = r0; v1 = r1; }
                    else if (t == 3) {
#pragma unroll
                        for (int j = 0; j < 4; ++j) { v0[j] = silu_f(v0[j]); v1[j] = silu_f(v1[j]); } }
                    u32x4 w; w.x = cvt_pk_bf16(v0[0], v0[1]); w.y = cvt_pk_bf16(v0[2], v0[3]); w.z = cvt_pk_bf16(v1[0], v1[1]); w.w = cvt_pk_bf16(v1[2], v1[3]);
                    PG8_ST16(rowp + bj * HALF, w); } }
    }
};
struct EpiYSS {
    static constexpr bool PERM = true, AFTER_DRAIN = false, RS_LDS = false; static constexpr int NST = 16; static constexpr bool FRESH_OK = true;
    bf16_t* Y; float* PS;
    __device__ __forceinline__ void operator()(const f32x4 (&acc)[2][2][4][2], const Unit& u, int wr, int wc, int fr, int fq, const PG8_LAS float* rsl, int wt) const {
        const int row0 = u.pm * BM + wr * 64 + fr, col0 = u.pn * BM + wc * 32 + 8 * fq;
#pragma unroll
        for (int ai = 0; ai < 2; ++ai)
#pragma unroll
            for (int m = 0; m < 4; ++m) { const int row = row0 + ai * HALF + m * 16; bf16_t* rowp = Y + (size_t)row * 4096 + col0; float ss = 0.f;
#pragma unroll
                for (int bj = 0; bj < 2; ++bj) { const f32x4 v0 = acc[ai][bj][m][0], v1 = acc[ai][bj][m][1];
                    ss += (v0[0] * v0[0] + v0[1] * v0[1]) + (v0[2] * v0[2] + v0[3] * v0[3]) + (v1[0] * v1[0] + v1[1] * v1[1]) + (v1[2] * v1[2] + v1[3] * v1[3]);
                    u32x4 w; w.x = cvt_pk_bf16(v0[0], v0[1]); w.y = cvt_pk_bf16(v0[2], v0[3]); w.z = cvt_pk_bf16(v1[0], v1[1]); w.w = cvt_pk_bf16(v1[2], v1[3]);
                    PG8_ST16(rowp + bj * HALF, w); }
                ss += __shfl_xor(ss, 16); ss += __shfl_xor(ss, 32);
                if (fq == 0) PS[(size_t)row * 64 + u.pn * 4 + wc] = ss; }
    }
};
struct EpiSwiGLU {
    static constexpr bool PERM = true, AFTER_DRAIN = false, RS_LDS = true; static constexpr int NST = 8; static constexpr bool FRESH_OK = true;
    bf16_t* Hh; const float* rs;
    __device__ __forceinline__ void operator()(const f32x4 (&acc)[2][2][4][2], const Unit& u, int wr, int wc, int fr, int fq, const PG8_LAS float* rsl, int wt) const {
        const int row0 = u.pm * BM + wr * 64 + fr, col0 = u.pn * HALF + wc * 32 + 8 * fq;
#pragma unroll
        for (int ai = 0; ai < 2; ++ai)
#pragma unroll
            for (int m = 0; m < 4; ++m) { const int row = row0 + ai * HALF + m * 16; const float r1 = rsl[row & 255];
                f32x4 h0, h1;
#pragma unroll
                for (int j = 0; j < 4; ++j) { h0[j] = silu_f(acc[ai][0][m][0][j] * r1) * (acc[ai][1][m][0][j] * r1); h1[j] = silu_f(acc[ai][0][m][1][j] * r1) * (acc[ai][1][m][1][j] * r1); }
                u32x4 w; w.x = cvt_pk_bf16(h0[0], h0[1]); w.y = cvt_pk_bf16(h0[2], h0[3]); w.z = cvt_pk_bf16(h1[0], h1[1]); w.w = cvt_pk_bf16(h1[2], h1[3]);
                if (MK_HTILED) PG8_ST16(Hh + (((size_t)u.pm * 172 + (col0 >> 6)) * 256 + (row & 255)) * 64 + (col0 & 63), w);
                else PG8_ST16(Hh + (size_t)row * 11008 + col0, w);
#ifdef MK_PROBE_DUPSTORE
                PG8_ST16(Hh + (size_t)268435456 + (size_t)row * 11008 + col0, w);
#endif
                }
    }
};
struct EpiKVQ {
    static constexpr bool PERM = true, AFTER_DRAIN = false, RS_LDS = true; static constexpr int NST = 16; static constexpr bool FRESH_OK = true;
    bf16_t* O; const float* rs;
    __device__ __forceinline__ void operator()(const f32x4 (&acc)[2][2][4][2], const Unit& u, int wr, int wc, int fr, int fq, const PG8_LAS float* rsl, int wt) const {
        const int row0 = u.pm * BM + wr * 64 + fr, t = u.pn >> 4, hp = u.pn & 15;
        bf16_t* base = O + (size_t)t * ((size_t)64 * 8192 * 128) + wc * 32 + 8 * fq;
#pragma unroll
        for (int ai = 0; ai < 2; ++ai)
#pragma unroll
            for (int m = 0; m < 4; ++m) { const int row = row0 + ai * HALF + m * 16, b = row >> 13, s = row & 8191; const float r1 = rsl[row & 255];
#pragma unroll
                for (int bj = 0; bj < 2; ++bj) { const f32x4 v0 = acc[ai][bj][m][0] * r1, v1 = acc[ai][bj][m][1] * r1;
                    u32x4 w; w.x = cvt_pk_bf16(v0[0], v0[1]); w.y = cvt_pk_bf16(v0[2], v0[3]); w.z = cvt_pk_bf16(v1[0], v1[1]); w.w = cvt_pk_bf16(v1[2], v1[3]);
                    PG8_ST16(base + ((size_t)(b * 32 + 2 * hp + bj) * 8192 + s) * 128, w); } }
    }
};
template <class Epi, class Sched, bool ALIGN_EPI = false, bool SP2 = false, bool ATILED = false  >
__device__ __forceinline__ void gemm_phase(PG8_LAS unsigned char* lds, const Gemm g, const Sched& S, const Epi& E, int wave_id  ) {
    const int lane = mk_lane(), wid = wave_id, tid = wid * 64 + lane, wr = wid >> 2, wc = wid & 3, fr = lane & 15, fq = lane >> 4;
    const int K = g.K, nt = K / BK;
    unsigned voffA[2], voffB[2];
#pragma unroll
    for (int i = 0; i < 2; ++i) { int R, C; stage_rc(tid * 16 + i * 8192, R, C); const int Rb = Epi::PERM ? ((R & ~31) + perm32(R & 31)) : R;
        voffA[i] = ATILED ? (unsigned)(R * BK + C) * 2u : (unsigned)(R * K + C) * 2u; voffB[i] = MK_BTILED ? (unsigned)(Rb * BK + C) * 2u : (unsigned)(Rb * K + C) * 2u; }
    const size_t kstep = (size_t)(BK * 2);
    const size_t hstep = (size_t)HALF * K * 2;
    const size_t tstep = 2 * hstep;
    const size_t kstepA = ATILED ? (size_t)(BM * BK * 2) : kstep, hstepA = ATILED ? (size_t)(HALF * BK * 2) : hstep;
    const size_t kstepB = MK_BTILED ? (size_t)(BM * BK * 2) : kstep, hstepB = MK_BTILED ? (size_t)(HALF * BK * 2) : hstep;
    const size_t istepA = ATILED ? (size_t)(64 * BK * 2) : (size_t)64 * K * 2, istepB = MK_BTILED ? (size_t)(64 * BK * 2) : (size_t)64 * K * 2;
    const unsigned ldsw = (unsigned)wid * 1024u;
    const int aoff = lds_byte(wr * 64 + fr, fq * 8), boff = lds_byte(wc * 32 + fr, fq * 8);
#define PG8_SA(b, h) (((b) * 2 + (h)) * HTB)
#define PG8_SB(b, h) ((4 + (b) * 2 + (h)) * HTB)
#ifndef MK_B_AUX
#define MK_B_AUX 0
#endif
#define PG8_STAGE(bufoff, gbase, voff) do { _Pragma("unroll") for (int _i = 0; _i < 2; ++_i) \
        __builtin_amdgcn_global_load_lds((const unsigned*)((const char*)(gbase) + (size_t)_i * (((bufoff) >= 4 * HTB) ? istepB : istepA) + (voff)[0]), (PG8_LAS unsigned*)(lds + (bufoff) + ldsw + _i * 8192), 16, 0, ((bufoff) >= 4 * HTB) ? MK_B_AUX : 0); } while (0)
#define PG8_LDA(dst, b, h) do { _Pragma("unroll") for (int m = 0; m < 4; ++m) _Pragma("unroll") for (int k = 0; k < 2; ++k) dst[m][k] = *(const PG8_LAS bf16x8*)(lds + PG8_SA(b, h) + aoff + m * 2048 + k * 1024); } while (0)
#define PG8_LDB(dst, b, h) do { _Pragma("unroll") for (int n = 0; n < 2; ++n) _Pragma("unroll") for (int k = 0; k < 2; ++k) dst[n][k] = *(const PG8_LAS bf16x8*)(lds + PG8_SB(b, h) + boff + n * 2048 + k * 1024); } while (0)
#define PG8_MMA(ai, bj, At, Bt) do { __builtin_amdgcn_s_setprio(1); _Pragma("unroll") for (int m = 0; m < 4; ++m) _Pragma("unroll") for (int n = 0; n < 2; ++n) _Pragma("unroll") for (int k = 0; k < 2; ++k) \
        acc[ai][bj][m][n] = __builtin_amdgcn_mfma_f32_16x16x32_bf16(Bt[n][k], At[m][k], acc[ai][bj][m][n], 0, 0, 0); __builtin_amdgcn_s_setprio(0); } while (0)
#define PG8_WAIT_V(n) asm volatile("s_waitcnt vmcnt(" #n ")" ::: "memory")
#define PG8_WAIT_VN(n) asm volatile("s_waitcnt vmcnt(%0)" :: "i"(n) : "memory")
#define PG8_WAIT_L(n) asm volatile("s_waitcnt lgkmcnt(" #n ")" ::: "memory")
#define PG8_BAR __builtin_amdgcn_s_barrier()
#define PG8_SCHED __builtin_amdgcn_sched_barrier(0)
    Unit cur, nxt; int ui = 0;
    if (!S.next(0, cur)) return;
    f32x4 acc[2][2][4][2];
#pragma unroll
    for (int a = 0; a < 2; ++a)
#pragma unroll
        for (int b = 0; b < 2; ++b)
#pragma unroll
            for (int m = 0; m < 4; ++m)
#pragma unroll
                for (int n = 0; n < 2; ++n) acc[a][b][m][n] = (f32x4){0.f, 0.f, 0.f, 0.f};
    bf16x8 At[4][2], B0[2][2], B1[2][2];
    const char* cA = (const char*)g.A + (size_t)cur.pm * tstep; const char* cB = (const char*)g.Bt + (size_t)cur.pn * tstep;
    S.a_ready(cur);
#define PG8_RS_DMA(pm_, slot_) do { if constexpr (Epi::RS_LDS) { if (wid == 0) { unsigned lo_ = (unsigned)lane * 16u; asm volatile("" : "+v"(lo_));     \
        __builtin_amdgcn_global_load_lds((const unsigned*)((const char*)(E.rs + (size_t)(pm_) * BM) + lo_), (PG8_LAS unsigned*)(lds + STAGE_BYTES + (slot_) * 1024), 16, 0, 0); } } } while (0)
    PG8_RS_DMA(cur.pm, 0);
    if constexpr (SP2) {
        PG8_STAGE(PG8_SB(0, 0), cB, voffB); PG8_STAGE(PG8_SB(0, 1), cB + hstepB, voffB); PG8_STAGE(PG8_SA(0, 0), cA, voffA); PG8_STAGE(PG8_SA(0, 1), cA + hstepA, voffA);
        if (wr == 1) PG8_BAR;
        PG8_WAIT_V(2); PG8_BAR;
        PG8_STAGE(PG8_SB(1, 0), cB + kstepB, voffB); PG8_STAGE(PG8_SA(1, 0), cA + kstepA, voffA); PG8_STAGE(PG8_SB(1, 1), cB + hstepB + kstepB, voffB);
        PG8_WAIT_V(6); PG8_BAR;
    } else {
        PG8_STAGE(PG8_SB(0, 0), cB, voffB); PG8_STAGE(PG8_SA(0, 0), cA, voffA); PG8_STAGE(PG8_SB(0, 1), cB + hstepB, voffB); PG8_STAGE(PG8_SA(0, 1), cA + hstepA, voffA);
        if (wr == 1) PG8_BAR;
        PG8_WAIT_V(4); PG8_BAR;
        PG8_STAGE(PG8_SB(1, 0), cB + kstepB, voffB); PG8_STAGE(PG8_SA(1, 0), cA + kstepA, voffA); PG8_STAGE(PG8_SB(1, 1), cB + hstepB + kstepB, voffB);
        PG8_WAIT_V(6); PG8_BAR;
    }
#define PG8_ITER_SP2(DO_A11, NWAIT) do { \
              \
            PG8_LDB(B0, 0, 0); PG8_LDB(B1, 0, 1); PG8_SCHED; PG8_LDA(At, 0, 0); if (DO_A11) PG8_STAGE(PG8_SA(1, 1), a1 + hstepA, voffA); \
            PG8_WAIT_VN(NWAIT); PG8_WAIT_L(0); PG8_BAR; PG8_MMA(0, 0, At, B0); PG8_MMA(0, 1, At, B1); PG8_BAR; PG8_SCHED; \
              \
            PG8_LDA(At, 0, 1); PG8_STAGE(PG8_SB(0, 0), b2, voffB); PG8_STAGE(PG8_SB(0, 1), b2 + hstepB, voffB); PG8_STAGE(PG8_SA(0, 0), a2, voffA); \
            PG8_WAIT_VN(NWAIT); PG8_WAIT_L(0); PG8_BAR; PG8_MMA(1, 0, At, B0); PG8_MMA(1, 1, At, B1); PG8_BAR; PG8_SCHED; \
              \
            PG8_LDB(B0, 1, 0); PG8_LDB(B1, 1, 1); PG8_SCHED; PG8_LDA(At, 1, 0); PG8_STAGE(PG8_SA(0, 1), a2 + hstepA, voffA); \
            PG8_WAIT_VN(NWAIT); PG8_WAIT_L(0); PG8_BAR; PG8_MMA(0, 0, At, B0); PG8_MMA(0, 1, At, B1); PG8_BAR; PG8_SCHED; \
              \
            PG8_LDA(At, 1, 1); PG8_STAGE(PG8_SB(1, 0), b3, voffB); PG8_STAGE(PG8_SB(1, 1), b3 + hstepB, voffB); PG8_STAGE(PG8_SA(1, 0), a3, voffA); \
            PG8_WAIT_V(8); PG8_WAIT_L(0); PG8_BAR; PG8_MMA(1, 0, At, B0); PG8_MMA(1, 1, At, B1); PG8_BAR; PG8_SCHED; } while (0)
    for (;;) {
        const bool has_next = S.next(ui + 1, nxt);
        const char* nA = has_next ? (const char*)g.A + (size_t)nxt.pm * tstep : cA; const char* nB = has_next ? (const char*)g.Bt + (size_t)nxt.pn * tstep : cB;
        int t0 = 0;
        if constexpr (SP2 && ALIGN_EPI && MK_FRESH && Epi::FRESH_OK) { if (ui > 0) {
            const char* a1 = cA + kstepA; const char* a2 = cA + 2 * kstepA; const char* b2 = cB + 2 * kstepB; const char* a3 = a2 + kstepA; const char* b3 = b2 + kstepB; (void)a1;
            PG8_ITER_SP2(false, 8 + Epi::NST); t0 = 2; } }
        for (int t = t0; t < nt; t += 2) {
            const bool last = (t == nt - 2);
            const char* a1 = cA + (size_t)(t + 1) * kstepA;
            const char* a2 = last ? nA : cA + (size_t)(t + 2) * kstepA; const char* b2 = last ? nB : cB + (size_t)(t + 2) * kstepB;
            const char* a3 = a2 + kstepA; const char* b3 = b2 + kstepB;
            if (last && has_next) S.a_ready(nxt);
            if constexpr (SP2) {
            PG8_ITER_SP2(true, 8);
            } else {
            PG8_LDB(B0, 0, 0); PG8_SCHED; PG8_LDA(At, 0, 0); PG8_STAGE(PG8_SA(1, 1), a1 + hstepA, voffA);
            PG8_WAIT_L(8); PG8_BAR; PG8_WAIT_L(0); PG8_MMA(0, 0, At, B0); PG8_BAR; PG8_SCHED;
            PG8_LDB(B1, 0, 1); PG8_STAGE(PG8_SB(0, 0), b2, voffB);
            PG8_BAR; PG8_WAIT_L(0); PG8_MMA(0, 1, At, B1); PG8_BAR;
            PG8_LDA(At, 0, 1); PG8_STAGE(PG8_SA(0, 0), a2, voffA);
            PG8_BAR; PG8_WAIT_L(0); PG8_MMA(1, 0, At, B0); PG8_BAR; PG8_SCHED;
            PG8_STAGE(PG8_SB(0, 1), b2 + hstepB, voffB);
            PG8_WAIT_V(6); PG8_BAR; PG8_MMA(1, 1, At, B1); PG8_BAR;
            PG8_LDB(B0, 1, 0); PG8_SCHED; PG8_LDA(At, 1, 0); PG8_STAGE(PG8_SA(0, 1), a2 + hstepA, voffA);
            PG8_WAIT_L(8); PG8_BAR; PG8_WAIT_L(0); PG8_MMA(0, 0, At, B0); PG8_BAR; PG8_SCHED;
            PG8_LDB(B1, 1, 1); PG8_STAGE(PG8_SB(1, 0), b3, voffB);
            PG8_BAR; PG8_WAIT_L(0); PG8_MMA(0, 1, At, B1); PG8_BAR;
            PG8_LDA(At, 1, 1); PG8_STAGE(PG8_SA(1, 0), a3, voffA);
            PG8_BAR; PG8_WAIT_L(0); PG8_MMA(1, 0, At, B0); PG8_BAR; PG8_SCHED;
            PG8_STAGE(PG8_SB(1, 1), b3 + hstepB, voffB);
            PG8_WAIT_V(6); PG8_BAR; PG8_MMA(1, 1, At, B1); PG8_BAR;
            }
        }
        if constexpr (ALIGN_EPI) { if (wr == 0) PG8_BAR; }
        if (has_next) PG8_RS_DMA(nxt.pm, (ui + 1) & 1);
        if constexpr (SP2 && ALIGN_EPI && MK_FRESH && Epi::FRESH_OK) { if (has_next) PG8_STAGE(PG8_SA(1, 1), nA + kstepA + hstepA, voffA); asm volatile("" ::: "memory"); PG8_SCHED; }
        if constexpr (!Epi::AFTER_DRAIN) { E(acc, cur, wr, wc, fr, fq, (const PG8_LAS float*)(lds + STAGE_BYTES + (ui & 1) * 1024), has_next ? 0 : 1); S.done(cur); }
        if (!has_next) break;
#pragma unroll
        for (int a = 0; a < 2; ++a)
#pragma unroll
            for (int b = 0; b < 2; ++b)
#pragma unroll
                for (int m = 0; m < 4; ++m)
#pragma unroll
                    for (int n = 0; n < 2; ++n) acc[a][b][m][n] = (f32x4){0.f, 0.f, 0.f, 0.f};
        cur = nxt; cA = nA; cB = nB; ++ui;
        if constexpr (ALIGN_EPI) { if (wr == 1) PG8_BAR; }
    }
    PG8_WAIT_V(0);
    if constexpr (!ALIGN_EPI) { if (wr == 0) PG8_BAR; }
    PG8_BAR;
    if constexpr (Epi::AFTER_DRAIN) { E.fused(acc, cur, wr, wc, fr, fq, lds, wid, lane); S.done(cur); }
#undef PG8_SA
#undef PG8_SB
#undef PG8_STAGE
#undef PG8_LDA
#undef PG8_LDB
#undef PG8_MMA
#undef PG8_RS_DMA
#undef PG8_ITER_SP2
#undef PG8_WAIT_V
#undef PG8_WAIT_VN
#undef PG8_WAIT_L
#undef PG8_BAR
#undef PG8_SCHED
}
}
namespace att {
constexpr int D = 128; constexpr float THR = 8.f; constexpr bool WSKIP = false;
constexpr float SCALE = 0.08838834764831845f;
constexpr int NW = 8, QBLK = 32, KVBLK = 64, QB = NW * QBLK;
constexpr int SHM_V = KVBLK * D * 2, SHM_K = KVBLK * D * 2;
constexpr int LDS_BYTES = 2 * SHM_V + 2 * SHM_K + NW * 64 * 4;

typedef short bf16x8 __attribute__((ext_vector_type(8)));
typedef short s16x4 __attribute__((ext_vector_type(4)));
typedef float f32x16 __attribute__((ext_vector_type(16)));
typedef float f32x4 __attribute__((ext_vector_type(4)));
typedef unsigned u32x4 __attribute__((ext_vector_type(4)));
template <class A, class Bt> struct same_t { static constexpr bool v = false; };
template <class A> struct same_t<A, A> { static constexpr bool v = true; };

#define KSWZ(row, colB) ((row) * 256 + ((colB) ^ (((row) & 7) << 4)))
#define SBAR() __builtin_amdgcn_sched_barrier(0)
__device__ __forceinline__ int v_st(int k, int c) { const int kk = (k & ~0xC) | ((k & 4) << 1) | ((k & 8) >> 1); return ((kk >> 3) * 4 + (c >> 5)) * 512 + ((kk & 7) * 32 + (c & 31)) * 2; }
__device__ __forceinline__ int v_rd_base(int lane) { return ((lane & 3) << 3) | (((lane >> 2) & 3) << 6) | (((lane >> 4) & 1) << 5) | (((lane >> 5) & 1) << 8); }
constexpr int v_rd_off(int d0, int ks, int half) { return d0 * 512 + ks * 4096 + half * 2048; }
__device__ __forceinline__ int crow(int r, int hi) { return (r & 3) + 8 * (r >> 2) + 4 * hi; }
__device__ __forceinline__ unsigned cvtpk(float lo, float hi) {
    unsigned r; asm volatile("v_cvt_pk_bf16_f32 %0, %1, %2" : "=v"(r) : "v"(lo), "v"(hi)); return r;
}
__device__ __forceinline__ bf16x8 pack8(f32x4 a, f32x4 b) {
    u32x4 w = {cvtpk(a[0], a[1]), cvtpk(a[2], a[3]), cvtpk(b[0], b[1]), cvtpk(b[2], b[3])};
    return *reinterpret_cast<bf16x8*>(&w);
}
template <class T> __device__ __forceinline__ bf16x8 load8(const T* p) {
    if constexpr (same_t<T, float>::v) { return pack8(*(const f32x4*)p, *(const f32x4*)(p + 4)); }
    else { return *reinterpret_cast<const bf16x8*>(p); }
}
__device__ __forceinline__ void mask_tile(f32x16& p0, f32x16& p1, int dq, unsigned W) {
    const float NEG = -__builtin_inff();
#pragma unroll
    for (int r = 0; r < 16; ++r) {
        const int c = (r & 3) + 8 * (r >> 2);
        if ((unsigned)(dq - c) >= W) p0[r] = NEG;
        if ((unsigned)(dq - c - 32) >= W) p1[r] = NEG;
    }
}
__device__ __forceinline__ void partialSM(f32x16& p0, f32x16& p1, float& m_reg, float& mn, float& alpha) {
    float pmax = p0[0]; for (int r = 1; r < 16; ++r) pmax = fmaxf(pmax, p0[r]); for (int r = 0; r < 16; ++r) pmax = fmaxf(pmax, p1[r]);
    { auto rr = __builtin_amdgcn_permlane32_swap(__float_as_uint(pmax), __float_as_uint(pmax), false, false);
      pmax = fmaxf(__uint_as_float(rr[0]), __uint_as_float(rr[1])); }
    constexpr float C2 = 1.4426950408889634f * SCALE;
    if (__builtin_expect(__all((pmax - m_reg) * SCALE <= THR), 1)) { mn = m_reg; alpha = 1.f; }
    else { mn = fmaxf(m_reg, pmax); alpha = __builtin_amdgcn_exp2f((m_reg - mn) * C2); m_reg = mn; }
    const float mnL = -mn * C2;
    for (int r = 0; r < 16; ++r) p0[r] = fmaf(p0[r], C2, mnL); for (int r = 0; r < 16; ++r) p1[r] = fmaf(p1[r], C2, mnL);
    for (int r = 0; r < 16; ++r) p0[r] = __builtin_amdgcn_exp2f(p0[r]);
}
__device__ __forceinline__ void finishSM(f32x16& p0, f32x16& p1, float alpha, float& l_reg, bf16x8& pa0, bf16x8& pa1, bf16x8& pa2, bf16x8& pa3) {
    for (int r = 0; r < 16; ++r) p1[r] = __builtin_amdgcn_exp2f(p1[r]);
    float ps = 0; for (int r = 0; r < 16; ++r) ps += p0[r]; for (int r = 0; r < 16; ++r) ps += p1[r];
    { auto rr = __builtin_amdgcn_permlane32_swap(__float_as_uint(ps), __float_as_uint(ps), false, false);
      ps = __uint_as_float(rr[0]) + __uint_as_float(rr[1]); }
    l_reg = l_reg * alpha + ps;
#define PK4(P, B_, OUT) do { unsigned a0 = cvtpk(P[B_+0], P[B_+1]), a1 = cvtpk(P[B_+2], P[B_+3]);                          \
        unsigned b0 = cvtpk(P[B_+4], P[B_+5]), b1 = cvtpk(P[B_+6], P[B_+7]);                                             \
        auto r0 = __builtin_amdgcn_permlane32_swap(a0, b0, false, false); auto r1 = __builtin_amdgcn_permlane32_swap(a1, b1, false, false); \
        u32x4 w = {r0[0], r1[0], r0[1], r1[1]}; OUT = *reinterpret_cast<bf16x8*>(&w); } while (0)
    PK4(p0, 0, pa0); PK4(p0, 8, pa1); PK4(p1, 0, pa2); PK4(p1, 8, pa3);
#undef PK4
}
template <int KB, bool SK>
__device__ __forceinline__ void qkt(f32x16& p0, f32x16& p1, const char* K_lds, int r32, int hi, const bf16x8* qr, bool act) {
    if (SK && !act) { const float NEG = -__builtin_inff();
#pragma unroll
        for (int r = 0; r < 16; ++r) { p0[r] = NEG; p1[r] = NEG; } return; }
    p0 = f32x16{}; p1 = f32x16{};
    const char* kb[4];
#pragma unroll
    for (int dd = 0; dd < 4; ++dd) kb[dd] = K_lds + KB * SHM_K + KSWZ(r32, (dd * 16 + hi * 8) * 2);
#pragma unroll
    for (int d0 = 0; d0 < 8; ++d0) { const char* a = kb[d0 & 3] + (d0 >> 2) * 128;
        bf16x8 b0 = *reinterpret_cast<const bf16x8*>(a);
        bf16x8 b1 = *reinterpret_cast<const bf16x8*>(a + 32 * 256);
        p0 = __builtin_amdgcn_mfma_f32_32x32x16_bf16(b0, qr[d0], p0, 0, 0, 0);
        p1 = __builtin_amdgcn_mfma_f32_32x32x16_bf16(b1, qr[d0], p1, 0, 0, 0); }
}
template <int VB, bool SK>
__device__ __forceinline__ void pv_tile(f32x16* o, int vb0, bf16x8 pa0, bf16x8 pa1, bf16x8 pa2, bf16x8 pa3, bool act) {
    if (SK && !act) return;
#define TRRD(dst, off) asm volatile("ds_read_b64_tr_b16 %0, %1 offset:%2" : "=&v"(dst) : "v"(vb0), "i"(off) : "memory")
#define PV_D0(d0) do { s16x4 l0, l1, l2, l3, h0, h1, h2, h3; constexpr int b_ = VB * SHM_V + v_rd_off(d0, 0, 0);     \
        TRRD(l0, b_); TRRD(h0, b_ + 2048); TRRD(l1, b_ + 4096); TRRD(h1, b_ + 6144); TRRD(l2, b_ + 8192); TRRD(h2, b_ + 10240); TRRD(l3, b_ + 12288); TRRD(h3, b_ + 14336); \
        asm volatile("s_waitcnt lgkmcnt(0)" ::: "memory"); SBAR();                 \
        o[d0] = __builtin_amdgcn_mfma_f32_32x32x16_bf16(pa0, (bf16x8){l0[0], l0[1], l0[2], l0[3], h0[0], h0[1], h0[2], h0[3]}, o[d0], 0, 0, 0);   \
        o[d0] = __builtin_amdgcn_mfma_f32_32x32x16_bf16(pa1, (bf16x8){l1[0], l1[1], l1[2], l1[3], h1[0], h1[1], h1[2], h1[3]}, o[d0], 0, 0, 0);   \
        o[d0] = __builtin_amdgcn_mfma_f32_32x32x16_bf16(pa2, (bf16x8){l2[0], l2[1], l2[2], l2[3], h2[0], h2[1], h2[2], h2[3]}, o[d0], 0, 0, 0);   \
        o[d0] = __builtin_amdgcn_mfma_f32_32x32x16_bf16(pa3, (bf16x8){l3[0], l3[1], l3[2], l3[3], h3[0], h3[1], h3[2], h3[3]}, o[d0], 0, 0, 0); } while (0)
    PV_D0(0); PV_D0(1); PV_D0(2); PV_D0(3);
#undef PV_D0
#undef TRRD
}

template <class TIn, class TOut> struct BlockRef { const TIn* Q; const TIn* K; const TIn* V; TOut* O; int P0; };
template <class TIn> struct Seam {
    bf16x8 qr[8];
    bf16x8 st_v0, st_v1, st_k0, st_k1; f32x4 sf0, sf1, sf2, sf3;
    f32x4 tq[16];
};
__device__ __forceinline__ int swa_jlo(int P0, int W) { const int lowk = P0 - W + 1; return lowk > 0 ? lowk / KVBLK : 0; }
#define ROW(p, k0, rr) ((p) + (size_t)((k0) + (rr)) * D + sc)
#define VMW() asm volatile("s_waitcnt vmcnt(0)" ::: "memory")
#define VMWN(n) asm volatile("s_waitcnt vmcnt(%0)" :: "i"(n) : "memory")
#define SLOAD_H(Kp, Vp, k0) do { S.st_v0 = load8<TIn>(ROW(Vp, k0, sr)); S.st_v1 = load8<TIn>(ROW(Vp, k0, 32 + sr));              \
                         S.st_k0 = load8<TIn>(ROW(Kp, k0, sr)); S.st_k1 = load8<TIn>(ROW(Kp, k0, 32 + sr)); } while (0)
#define SWRITE_HK(bf) do { *(bf16x8*)(K_lds + (bf) * SHM_K + kws) = S.st_k0; *(bf16x8*)(K_lds + (bf) * SHM_K + kws + 32 * 256) = S.st_k1; } while (0)
#define SWRITE_HV(bf) do { *(bf16x8*)(V_lds + (bf) * SHM_V + vst0) = S.st_v0; *(bf16x8*)(V_lds + (bf) * SHM_V + vst1) = S.st_v1; } while (0)
#define SWRITE_H(bf) do { SWRITE_HV(bf); SWRITE_HK(bf); } while (0)
#define SLOAD_F(p, k0) do { S.sf0 = *(const f32x4*)ROW(p, k0, sr); S.sf1 = *(const f32x4*)(ROW(p, k0, sr) + 4);                \
                            S.sf2 = *(const f32x4*)ROW(p, k0, 32 + sr); S.sf3 = *(const f32x4*)(ROW(p, k0, 32 + sr) + 4); } while (0)
#define SWRITE_KF(bf) do { *(bf16x8*)(K_lds + (bf) * SHM_K + kws) = pack8(S.sf0, S.sf1); *(bf16x8*)(K_lds + (bf) * SHM_K + kws + 32 * 256) = pack8(S.sf2, S.sf3); } while (0)
#define SWRITE_VF(bf) do { *(bf16x8*)(V_lds + (bf) * SHM_V + vst0) = pack8(S.sf0, S.sf1); *(bf16x8*)(V_lds + (bf) * SHM_V + vst1) = pack8(S.sf2, S.sf3); } while (0)
template <class TIn, class TOut>
__device__ __forceinline__ void causal_swa_prime(const BlockRef<TIn, TOut>& cur, int W, char* lds, Seam<TIn>& S) {
    constexpr bool F32 = same_t<TIn, float>::v;
    const int tid = threadIdx.x, wid = __builtin_amdgcn_readfirstlane(tid >> 6), lane = tid & 63, r32 = lane & 31, hi = lane >> 5;
    const int sr = tid >> 4, sc = (tid & 15) * 8, kws = KSWZ(sr, sc * 2); char* K_lds = lds + 2 * SHM_V;
    const int kb0 = swa_jlo(cur.P0, W) * KVBLK;
    for (int d0 = 0; d0 < 8; ++d0) S.qr[d0] = load8<TIn>(cur.Q + (size_t)(wid * QBLK + r32) * D + d0 * 16 + hi * 8);
    if constexpr (F32) { SLOAD_F((const float*)cur.K, kb0); VMW(); SWRITE_KF(0); SBAR(); SLOAD_F((const float*)cur.V, kb0); }
    else { SLOAD_H(cur.K, cur.V, kb0); VMW(); SWRITE_HK(0); }
    __syncthreads();
}
template <class TIn, class TOut>
__device__ __forceinline__ void causal_swa_block(const BlockRef<TIn, TOut>& cur, const BlockRef<TIn, TOut>& nxt, int skv, int W, char* lds, Seam<TIn>& S) {
    constexpr bool F32 = same_t<TIn, float>::v;
    const int tid = threadIdx.x, wid = __builtin_amdgcn_readfirstlane(tid >> 6), lane = tid & 63, r32 = lane & 31, hi = lane >> 5;
    const int j_lo = swa_jlo(cur.P0, W);
    int j_hi = (cur.P0 + QB - 1) / KVBLK + 1; if (j_hi > skv / KVBLK) j_hi = skv / KVBLK;
    const int NT = j_hi - j_lo;
    const int kbn = swa_jlo(nxt.P0, W) * KVBLK;
    const int qlo = cur.P0 + wid * QBLK, qm = qlo + r32 - 4 * hi;
    char* V_lds = lds; char* K_lds = lds + 2 * SHM_V;
    float* ws = (float*)(lds + 2 * SHM_V + 2 * SHM_K) + wid * 64; float* li_l = ws, * al_l = ws + 32;
    float m_reg = -1e30f, l_reg = 0; f32x16 o[4] = {};
    const int sr = tid >> 4, sc = (tid & 15) * 8, vst0 = v_st(sr, sc), vst1 = v_st(32 + sr, sc), kws = KSWZ(sr, sc * 2);
    const int vb0 = (int)(uintptr_t)V_lds + v_rd_base(lane);
    const TIn* Kh = cur.K; const TIn* Vh = cur.V;
#define RESC(a) do { if (__any((a) < 1.f)) { if (hi == 0) al_l[r32] = (a); asm volatile("s_waitcnt lgkmcnt(0)" ::: "memory");              \
                     for (int d_ = 0; d_ < 4; ++d_) for (int r = 0; r < 16; ++r) o[d_][r] *= al_l[crow(r, hi)]; } } while (0)
#define KBASE(t) ((j_lo + (t)) * KVBLK)
#define ACT(t) (KBASE(t) <= qlo + QBLK - 1 && KBASE(t) + KVBLK - 1 >= qlo - W + 1)
#define MASKT(P0_, P1_, t) do { const int kb_ = KBASE(t); if ((!SK || ACT(t)) && (kb_ + KVBLK - 1 > qlo || kb_ <= qlo + QBLK - 1 - W)) mask_tile(P0_, P1_, qm - kb_, (unsigned)W); } while (0)
    constexpr int NQL = F32 ? 16 : 8;
    constexpr bool SK = WSKIP && !F32;
#define SEAM_K0() do { VMWN(NQL); if constexpr (F32) { SWRITE_KF(0); SBAR(); SLOAD_F((const float*)nxt.V, kbn); } else { SWRITE_HK(0); } SBAR(); } while (0)
    f32x16 pA0, pA1, pB0, pB1; float mnA, mnB, alA, alB; bf16x8 pa0, pa1, pa2, pa3;
    if constexpr (F32) { VMW(); SWRITE_VF(0); SBAR(); } else { SWRITE_HV(0); SBAR(); }
    if (NT > 1) { if constexpr (F32) SLOAD_F((const float*)Kh, KBASE(1)); else SLOAD_H(Kh, Vh, KBASE(1)); }
    SBAR(); qkt<0, SK>(pA0, pA1, K_lds, r32, hi, S.qr, ACT(0));
    if constexpr (F32) { if (NT > 1) { VMW(); SWRITE_KF(1); SBAR(); SLOAD_F((const float*)Vh, KBASE(1)); } }
    MASKT(pA0, pA1, 0); partialSM(pA0, pA1, m_reg, mnA, alA);
    if (NT > 1) { VMW(); if constexpr (F32) { SWRITE_VF(1); SBAR(); if (NT > 2) SLOAD_F((const float*)Kh, KBASE(2)); } else SWRITE_H(1); }
    __syncthreads();
#define HALF_STEP(PX0, PX1, mnX, alX, PY0, PY1, alY, t, KB, VB, SB) do {                                                      \
        SBAR(); qkt<KB, SK>(PX0, PX1, K_lds, r32, hi, S.qr, ACT(t));                                             \
        finishSM(PY0, PY1, alY, l_reg, pa0, pa1, pa2, pa3); SBAR();                                                           \
        if ((t) + 1 < NT) { if constexpr (F32) { VMW(); SWRITE_KF(SB); SBAR(); SLOAD_F((const float*)Vh, KBASE((t) + 1)); }  \
                            else { SLOAD_H(Kh, Vh, KBASE((t) + 1)); } SBAR(); }                                               \
        pv_tile<VB, SK>(o, vb0, pa0, pa1, pa2, pa3, ACT((t) - 1)); MASKT(PX0, PX1, (t)); partialSM(PX0, PX1, m_reg, mnX, alX);                                        \
        __syncthreads();                                                                                                      \
        if ((t) + 1 < NT) { VMW(); if constexpr (F32) { SWRITE_VF(SB); SBAR(); if ((t) + 2 < NT) SLOAD_F((const float*)Kh, KBASE((t) + 2)); } \
                            else { SWRITE_H(SB); } }                                                                          \
        RESC(alX); __syncthreads(); } while (0)
    for (int t = 1; t + 1 < NT; t += 2) {
        HALF_STEP(pB0, pB1, mnB, alB, pA0, pA1, alA, t, 1, 0, 0);
        HALF_STEP(pA0, pA1, mnA, alA, pB0, pB1, alB, t + 1, 0, 1, 1);
    }
    const bool even = (NT & 1) == 0;
    if (even) { SBAR(); qkt<1, SK>(pB0, pB1, K_lds, r32, hi, S.qr, ACT(NT - 1)); SBAR(); }
#define QROW(e) (nxt.Q + (size_t)(wid * QBLK + r32) * D + ((e) >> 1) * 16 + hi * 8 + ((e) & 1) * 4)
    if constexpr (F32) { SLOAD_F((const float*)nxt.K, kbn); SBAR();
#pragma unroll
        for (int e = 0; e < 8; ++e) S.tq[e] = *(const f32x4*)QROW(e); }
    else { SLOAD_H(nxt.K, nxt.V, kbn); SBAR();
#pragma unroll
        for (int d0 = 0; d0 < 8; ++d0) S.qr[d0] = load8<TIn>(nxt.Q + (size_t)(wid * QBLK + r32) * D + d0 * 16 + hi * 8); }
    SBAR();
    finishSM(pA0, pA1, alA, l_reg, pa0, pa1, pa2, pa3); SBAR();
    if constexpr (F32) {
#pragma unroll
        for (int e = 8; e < 16; ++e) S.tq[e] = *(const f32x4*)QROW(e); SBAR(); }
#undef QROW
    pv_tile<0, SK>(o, vb0, pa0, pa1, pa2, pa3, ACT(even ? NT - 2 : NT - 1));
    if (even) { MASKT(pB0, pB1, NT - 1); partialSM(pB0, pB1, m_reg, mnB, alB); __syncthreads(); RESC(alB);
        finishSM(pB0, pB1, alB, l_reg, pa0, pa1, pa2, pa3); SBAR(); pv_tile<1, SK>(o, vb0, pa0, pa1, pa2, pa3, ACT(NT - 1)); }
    SBAR(); SEAM_K0();
    if (hi == 0) li_l[r32] = l_reg; asm volatile("s_waitcnt lgkmcnt(0)" ::: "memory");
    float rli[16];
#pragma unroll
    for (int r = 0; r < 16; ++r) rli[r] = __builtin_amdgcn_rcpf(li_l[crow(r, hi)]);
    TOut* Ow = cur.O + (size_t)(wid * QBLK) * D;
#pragma unroll
    for (int r = 0; r < 16; ++r) { const int orow = crow(r, hi);
#pragma unroll
        for (int d0 = 0; d0 < 4; ++d0) { const float v = o[d0][r] * rli[r];
            if constexpr (same_t<TOut, float>::v) { Ow[(size_t)orow * D + d0 * 32 + r32] = v; }
            else { const float vn = __shfl_xor(v, 1);
                   if ((r32 & 1) == 0) *(unsigned*)(Ow + (size_t)orow * D + d0 * 32 + r32) = cvtpk(v, vn); } } }
    if constexpr (F32) {
#pragma unroll
        for (int d0 = 0; d0 < 8; ++d0) S.qr[d0] = pack8(S.tq[2 * d0], S.tq[2 * d0 + 1]); }
    __syncthreads();
#undef RESC
#undef KBASE
#undef ACT
#undef MASKT
#undef SEAM_K0
#undef HALF_STEP
}
#undef ROW
#undef VMW
#undef VMWN
#undef SLOAD_H
#undef SWRITE_HK
#undef SWRITE_HV
#undef SWRITE_H
#undef SLOAD_F
#undef SWRITE_KF
#undef SWRITE_VF

template <int VB0>
__device__ __forceinline__ void pv8(f32x16* o, int vb0, bf16x8 pa0, bf16x8 pa1, bf16x8 pa2, bf16x8 pa3) {
    s16x4 l0, h0, l1, h1, l2, h2, l3, h3;
#define TRRD(dst, off) asm volatile("ds_read_b64_tr_b16 %0, %1 offset:%2" : "=&v"(dst) : "v"(vb0), "i"(off) : "memory")
#define PV8_OFF(d0) ((VB0 + ((d0) >> 2)) * SHM_V + v_rd_off((d0) & 3, 0, 0))
#define PV8_RX(d0) do { TRRD(l0, PV8_OFF(d0)); TRRD(h0, PV8_OFF(d0) + 2048); TRRD(l1, PV8_OFF(d0) + 4096); TRRD(h1, PV8_OFF(d0) + 6144); } while (0)
#define PV8_RY(d0) do { TRRD(l2, PV8_OFF(d0) + 8192); TRRD(h2, PV8_OFF(d0) + 10240); TRRD(l3, PV8_OFF(d0) + 12288); TRRD(h3, PV8_OFF(d0) + 14336); } while (0)
#define PV8_STEP(d0, LAST) do { \
        asm volatile("s_waitcnt lgkmcnt(4)" ::: "memory"); SBAR(); \
        o[d0] = __builtin_amdgcn_mfma_f32_32x32x16_bf16(pa0, (bf16x8){l0[0], l0[1], l0[2], l0[3], h0[0], h0[1], h0[2], h0[3]}, o[d0], 0, 0, 0); \
        o[d0] = __builtin_amdgcn_mfma_f32_32x32x16_bf16(pa1, (bf16x8){l1[0], l1[1], l1[2], l1[3], h1[0], h1[1], h1[2], h1[3]}, o[d0], 0, 0, 0); SBAR(); \
        if (!(LAST)) { PV8_RX((d0) + 1); asm volatile("s_waitcnt lgkmcnt(4)" ::: "memory"); } else { asm volatile("s_waitcnt lgkmcnt(0)" ::: "memory"); } SBAR(); \
        o[d0] = __builtin_amdgcn_mfma_f32_32x32x16_bf16(pa2, (bf16x8){l2[0], l2[1], l2[2], l2[3], h2[0], h2[1], h2[2], h2[3]}, o[d0], 0, 0, 0); \
        o[d0] = __builtin_amdgcn_mfma_f32_32x32x16_bf16(pa3, (bf16x8){l3[0], l3[1], l3[2], l3[3], h3[0], h3[1], h3[2], h3[3]}, o[d0], 0, 0, 0); SBAR(); \
        if (!(LAST)) PV8_RY((d0) + 1); } while (0)
    PV8_RX(0); PV8_RY(0);
    PV8_STEP(0, false); PV8_STEP(1, false); PV8_STEP(2, false); PV8_STEP(3, false); PV8_STEP(4, false); PV8_STEP(5, false); PV8_STEP(6, false); PV8_STEP(7, true);
#undef PV8_STEP
#undef PV8_RY
#undef PV8_RX
#undef PV8_OFF
#undef TRRD
}
struct Ref2 { const unsigned short* Q; const unsigned short* K; const unsigned short* V0; const unsigned short* V1; float* X; unsigned short* RA; float lam; int P0; int wt; };
constexpr int A2_LDS = 4 * SHM_V + 2 * SHM_K + NW * 64 * 4;
template <int MODE  >
__device__ __forceinline__ void attn2_block(const Ref2& cur, char* lds, int wave_id) {
    typedef unsigned short T;
    constexpr int W = 1 << 20;
    const int lane = mk_lane(), wid = wave_id, r32 = lane & 31, hi = lane >> 5;
    const int NT = (cur.P0 + QB) / KVBLK;
    const int qlo = cur.P0 + wid * QBLK, qm = qlo + r32 - 4 * hi;
    char* V_lds = lds; char* K_lds = lds + 4 * SHM_V;
    float* ws = (float*)(lds + 4 * SHM_V + 2 * SHM_K) + wid * 64; float* li_l = ws; float* al_l = ws + 32;
    const int vb0 = (int)(uintptr_t)V_lds + v_rd_base(lane);
    bf16x8 qr[8];
#pragma unroll
    for (int d0 = 0; d0 < 8; ++d0) qr[d0] = load8<T>(cur.Q + (size_t)(wid * QBLK + r32) * D + d0 * 16 + hi * 8);
    const unsigned krow = 4 * wid + (lane >> 4), kgo = krow * 256 + (((lane & 15) * 16) ^ ((krow & 7) << 4));
    const unsigned vkk = 8 * (wid >> 1) + ((lane & 31) >> 2), vk = (vkk & ~0xCu) | ((vkk & 4) << 1) | ((vkk & 8) >> 1), vgo = vk * 256 + (32 * (2 * (wid & 1) + (lane >> 5)) + 8 * (lane & 3)) * 2;
    typedef __attribute__((address_space(3))) unsigned lds_u32;
#define A2_DMA(k0, bf) do { const char* kp_ = (const char*)cur.K + (size_t)(k0) * 256; const char* v0_ = (const char*)cur.V0 + (size_t)(k0) * 256; const char* v1_ = (const char*)cur.V1 + (size_t)(k0) * 256; \
        char* kl_ = K_lds + (bf) * SHM_K + wid * 1024; char* vl_ = V_lds + (2 * (bf)) * SHM_V + wid * 1024; \
        __builtin_amdgcn_global_load_lds((const unsigned*)(kp_ + kgo), (lds_u32*)kl_, 16, 0, 0); __builtin_amdgcn_global_load_lds((const unsigned*)(kp_ + 8192 + kgo), (lds_u32*)(kl_ + 8192), 16, 0, 0); \
        __builtin_amdgcn_global_load_lds((const unsigned*)(v0_ + vgo), (lds_u32*)vl_, 16, 0, 0); __builtin_amdgcn_global_load_lds((const unsigned*)(v0_ + 8192 + vgo), (lds_u32*)(vl_ + 8192), 16, 0, 0); \
        __builtin_amdgcn_global_load_lds((const unsigned*)(v1_ + vgo), (lds_u32*)(vl_ + SHM_V), 16, 0, 0); __builtin_amdgcn_global_load_lds((const unsigned*)(v1_ + 8192 + vgo), (lds_u32*)(vl_ + SHM_V + 8192), 16, 0, 0); } while (0)
    A2_DMA(0, 0);
    asm volatile("s_waitcnt vmcnt(0)" ::: "memory"); __syncthreads();
    float m_reg = -1e30f, l_reg = 0.f; f32x16 o[8] = {};
#define A2_STEP(t, BF) do { \
        f32x16 p0, p1; SBAR(); qkt<BF, false>(p0, p1, K_lds, r32, hi, qr, true); SBAR(); \
        if ((t) + 1 < NT) A2_DMA(((t) + 1) * KVBLK, 1 - BF);     \
        SBAR(); \
        { const int kb_ = (t) * KVBLK; if (kb_ + KVBLK - 1 > qlo) mask_tile(p0, p1, qm - kb_, (unsigned)W); } \
        float mn, al; partialSM(p0, p1, m_reg, mn, al); bf16x8 pa0, pa1, pa2, pa3; finishSM(p0, p1, al, l_reg, pa0, pa1, pa2, pa3); SBAR(); \
        if (__any(al < 1.f)) { if (hi == 0) al_l[r32] = al; asm volatile("s_waitcnt lgkmcnt(0)" ::: "memory"); \
            _Pragma("unroll") for (int r = 0; r < 16; ++r) { const float a_ = al_l[crow(r, hi)]; _Pragma("unroll") for (int d_ = 0; d_ < 8; ++d_) o[d_][r] *= a_; } } \
        pv8<2 * BF>(o, vb0, pa0, pa1, pa2, pa3); \
        asm volatile("s_waitcnt vmcnt(0)" ::: "memory"); __syncthreads(); } while (0)
    for (int t = 0; t < NT; t += 2) { A2_STEP(t, 0); A2_STEP(t + 1, 1); }
#undef A2_STEP
#undef A2_DMA
    int r32e = r32, hie = hi, le = lane; asm volatile("" : "+v"(r32e), "+v"(hie), "+v"(le));
    if (hie == 0) li_l[r32e] = l_reg; asm volatile("s_waitcnt lgkmcnt(0)" ::: "memory");
#pragma unroll
    for (int r = 0; r < 16; ++r) { const float rl = __builtin_amdgcn_rcpf(li_l[crow(r, hie)]);
#pragma unroll
        for (int d0 = 0; d0 < 8; ++d0) o[d0][r] *= rl; }
    u32x4* Xw = (u32x4*)cur.X + (size_t)wid * (16 * 64) + le;
    if (MODE == 0) {
#pragma unroll
        for (int d0 = 0; d0 < 8; ++d0)
#pragma unroll
            for (int r8 = 0; r8 < 2; ++r8) { u32x4 w; w.x = cvtpk(o[d0][8 * r8], o[d0][8 * r8 + 1]); w.y = cvtpk(o[d0][8 * r8 + 2], o[d0][8 * r8 + 3]); w.z = cvtpk(o[d0][8 * r8 + 4], o[d0][8 * r8 + 5]); w.w = cvtpk(o[d0][8 * r8 + 6], o[d0][8 * r8 + 7]);
                Xw[(2 * d0 + r8) * 64] = w; }
    } else {
        const float lam = cur.lam;
#pragma unroll
        for (int d0 = 0; d0 < 8; ++d0)
#pragma unroll
            for (int r8 = 0; r8 < 2; ++r8) { const u32x4 a = Xw[(2 * d0 + r8) * 64];
#pragma unroll
                for (int e = 0; e < 4; ++e) { const unsigned w = a[e]; const int r0 = 8 * r8 + 2 * e;
                    o[d0][r0] = __builtin_bit_cast(float, w << 16) - lam * o[d0][r0]; o[d0][r0 + 1] = __builtin_bit_cast(float, w & 0xffff0000u) - lam * o[d0][r0 + 1]; } }
#pragma unroll
        for (int r = 0; r < 16; ++r) { float ss = 0.f;
#pragma unroll
            for (int d0 = 0; d0 < 8; ++d0) ss += o[d0][r] * o[d0][r];
            ss += __shfl_xor(ss, 1); ss += __shfl_xor(ss, 2); ss += __shfl_xor(ss, 4); ss += __shfl_xor(ss, 8); ss += __shfl_xor(ss, 16);
            const float rs_ = __builtin_amdgcn_rsqf(ss * (1.0f / 256.0f) + 1e-5f);
#pragma unroll
            for (int d0 = 0; d0 < 8; ++d0) o[d0][r] *= rs_; }
        char* stg = lds + wid * (32 * 136 * 2);
#pragma unroll
        for (int hf = 0; hf < 2; ++hf) {
#pragma unroll
            for (int r = 0; r < 16; ++r)
#pragma unroll
                for (int d4 = 0; d4 < 4; ++d4) { const float v = o[4 * hf + d4][r]; unsigned short b_; { unsigned u_ = __builtin_bit_cast(unsigned, v); b_ = (unsigned short)((u_ + 0x7fffu + ((u_ >> 16) & 1u)) >> 16); }
                    *(unsigned short*)(stg + (crow(r, hie) * 136 + d4 * 32 + r32e) * 2) = b_; }
            asm volatile("" ::: "memory");
#pragma unroll
            for (int j = 0; j < 8; ++j) { const int row = 4 * j + (le >> 4), ch = le & 15; const u32x4 w = *(const u32x4*)(stg + (row * 136 + ch * 8) * 2);
                *(u32x4*)(cur.RA + (size_t)(wid * QBLK + row) * 4096 + hf * 128 + ch * 8) = w; }
            asm volatile("" ::: "memory");
        }
        __syncthreads();
    }
}
constexpr int A16_V = 32768, A16_K = 16384, A16_KOFF = 2 * A16_V, A16_STAT = A16_KOFF + 2 * A16_K;
typedef __attribute__((address_space(3))) unsigned char a16_lds;
__device__ __forceinline__ bf16x8 a16_cat(s16x4 a, s16x4 b) { return (bf16x8){a[0], a[1], a[2], a[3], b[0], b[1], b[2], b[3]}; }
template <int MODE>
__device__ __forceinline__ void attn16_block(const Ref2& cur, char* lds_g, int wave_id) {
    typedef unsigned short T; typedef __attribute__((address_space(3))) unsigned lds_u32;
    const int lane = mk_lane(), wid = wave_id, fr = lane & 15, fq = lane >> 4, qq = (lane & 15) >> 2, pp = lane & 3;
    const int NT = (cur.P0 + QB) / KVBLK, qlo = cur.P0 + wid * QBLK;
    a16_lds* L = (a16_lds*)lds_g;
    __attribute__((address_space(3))) float* li_l = (__attribute__((address_space(3))) float*)(L + A16_STAT + wid * 256); __attribute__((address_space(3))) float* al_l = li_l + 32;
    bf16x8 qf[2][4];
#pragma unroll
    for (int qb = 0; qb < 2; ++qb)
#pragma unroll
        for (int ks = 0; ks < 4; ++ks) qf[qb][ks] = load8<T>(cur.Q + (size_t)(wid * QBLK + 16 * qb + fr) * D + 32 * ks + 8 * fq);
    const T* Vsrc = ((wid & 3) >> 1) ? cur.V1 : cur.V0;
#define A16_DMA(k0, bf) do { const int ld_ = mk_lane(); int kR, kC; pg8::stage_rc(wid * 1024 + ld_ * 16, kR, kC); const unsigned kgo = (unsigned)(kR * 128 + kC) * 2u; \
        const unsigned vgo = (unsigned)(8 * (wid >> 2) + ((ld_ >> 1) & 7)) * 256u + (unsigned)(16 * ((4 * (wid & 3) + (ld_ >> 4)) & 7) + 8 * (ld_ & 1)) * 2u; const char* kp_ = (const char*)cur.K + (size_t)(k0) * 256; const char* vp_ = (const char*)Vsrc + (size_t)(k0) * 256; \
        char* kl_ = lds_g + A16_KOFF + (bf) * A16_K + wid * 1024; char* vl_ = lds_g + (bf) * A16_V + wid * 1024; \
        __builtin_amdgcn_global_load_lds((const unsigned*)(kp_ + kgo), (lds_u32*)kl_, 16, 0, 0); __builtin_amdgcn_global_load_lds((const unsigned*)(kp_ + 128 + kgo), (lds_u32*)(kl_ + 8192), 16, 0, 0); \
        __builtin_amdgcn_global_load_lds((const unsigned*)(vp_ + vgo), (lds_u32*)vl_, 16, 0, 0); __builtin_amdgcn_global_load_lds((const unsigned*)(vp_ + 4096 + vgo), (lds_u32*)(vl_ + 8192), 16, 0, 0); \
        __builtin_amdgcn_global_load_lds((const unsigned*)(vp_ + 8192 + vgo), (lds_u32*)(vl_ + 16384), 16, 0, 0); __builtin_amdgcn_global_load_lds((const unsigned*)(vp_ + 12288 + vgo), (lds_u32*)(vl_ + 24576), 16, 0, 0); } while (0)
    A16_DMA(0, 0);
    asm volatile("s_waitcnt vmcnt(0)" ::: "memory"); __syncthreads();
    const int kbase = pg8::lds_byte(fr, 8 * fq);
    const int vbase = (fq >> 1) * 4096 + (4 * (fq & 1) + qq) * 32 + 8 * pp;
    float mref[2] = {0.f, 0.f}, l_reg[2] = {0.f, 0.f};
    f32x4 o[2][16];
#pragma unroll
    for (int qb = 0; qb < 2; ++qb)
#pragma unroll
        for (int vb = 0; vb < 16; ++vb) o[qb][vb] = (f32x4){0.f, 0.f, 0.f, 0.f};
    constexpr float PBIG = 1073741824.f;
#define A16_FADD(a_, b_) ((a_) + (b_))
#define A16_ROWRED(v_, OP) do { auto r16_ = __builtin_amdgcn_permlane16_swap(__float_as_uint(v_), __float_as_uint(v_), false, false); v_ = OP(__uint_as_float(r16_[0]), __uint_as_float(r16_[1])); \
        auto r32_ = __builtin_amdgcn_permlane32_swap(__float_as_uint(v_), __float_as_uint(v_), false, false); v_ = OP(__uint_as_float(r32_[0]), __uint_as_float(r32_[1])); } while (0)
    const int kaddr0 = (int)(unsigned)(uintptr_t)(L + A16_KOFF + kbase), vaddr0 = (int)(unsigned)(uintptr_t)(L + vbase);
#define A16_KRD(dst, off) asm volatile("ds_read_b128 %0, %1 offset:%2" : "=&v"(dst) : "v"(kaddr0), "i"(off) : "memory")
#define A16_VRD(dst, off) asm volatile("ds_read_b64_tr_b16 %0, %1 offset:%2" : "=&v"(dst) : "v"(vaddr0), "i"(off) : "memory")
#define A16_LW(n) do { asm volatile("s_waitcnt lgkmcnt(" #n ")" ::: "memory"); SBAR(); } while (0)
#define A16_KOFFS(BF, ks, kb) ((BF) * A16_K + ((ks) >> 1) * 8192 + (kb) * 2048 + ((ks) & 1) * 1024)
#define A16_KG(BF, g, x0, x1) do { A16_KRD(x0, A16_KOFFS(BF, (g) >> 1, 2 * ((g) & 1))); A16_KRD(x1, A16_KOFFS(BF, (g) >> 1, 2 * ((g) & 1) + 1)); } while (0)
#define A16_KM0(g, x0, x1) do { const f32x4 ctup[2] = {{mref[0], mref[0], mref[0], mref[0]}, {mref[1], mref[1], mref[1], mref[1]}};     \
        s[0][2 * ((g) & 1)] = __builtin_amdgcn_mfma_f32_16x16x32_bf16(x0, qf[0][(g) >> 1], ctup[0], 0, 0, 0); s[1][2 * ((g) & 1)] = __builtin_amdgcn_mfma_f32_16x16x32_bf16(x0, qf[1][(g) >> 1], ctup[1], 0, 0, 0); \
        s[0][2 * ((g) & 1) + 1] = __builtin_amdgcn_mfma_f32_16x16x32_bf16(x1, qf[0][(g) >> 1], ctup[0], 0, 0, 0); s[1][2 * ((g) & 1) + 1] = __builtin_amdgcn_mfma_f32_16x16x32_bf16(x1, qf[1][(g) >> 1], ctup[1], 0, 0, 0); } while (0)
#define A16_KM(g, x0, x1) do { \
        s[0][2 * ((g) & 1)] = __builtin_amdgcn_mfma_f32_16x16x32_bf16(x0, qf[0][(g) >> 1], s[0][2 * ((g) & 1)], 0, 0, 0); s[1][2 * ((g) & 1)] = __builtin_amdgcn_mfma_f32_16x16x32_bf16(x0, qf[1][(g) >> 1], s[1][2 * ((g) & 1)], 0, 0, 0); \
        s[0][2 * ((g) & 1) + 1] = __builtin_amdgcn_mfma_f32_16x16x32_bf16(x1, qf[0][(g) >> 1], s[0][2 * ((g) & 1) + 1], 0, 0, 0); s[1][2 * ((g) & 1) + 1] = __builtin_amdgcn_mfma_f32_16x16x32_bf16(x1, qf[1][(g) >> 1], s[1][2 * ((g) & 1) + 1], 0, 0, 0); } while (0)
#define A16_VOFFS(BF, i) ((BF) * A16_V + (4 * ((i) >> 4)) * 4096 + ((i) & 15) * 256)
#define A16_VG(BF, i, y0, y1) do { A16_VRD(y0, A16_VOFFS(BF, i)); A16_VRD(y1, A16_VOFFS(BF, i) + 2 * 4096); } while (0)
#define A16_VM(i, y0, y1) do { const bf16x8 vf_ = a16_cat(y0, y1); \
        o[0][(i) & 15] = __builtin_amdgcn_mfma_f32_16x16x32_bf16(pa[0][(i) >> 4], vf_, o[0][(i) & 15], 0, 0, 0); o[1][(i) & 15] = __builtin_amdgcn_mfma_f32_16x16x32_bf16(pa[1][(i) >> 4], vf_, o[1][(i) & 15], 0, 0, 0); } while (0)
#define A16_E1(i) do { s[(i) >> 3][((i) >> 2) & 1][(i) & 3] = __builtin_amdgcn_exp2f(s[(i) >> 3][((i) >> 2) & 1][(i) & 3]); ps[(i) >> 3] += s[(i) >> 3][((i) >> 2) & 1][(i) & 3]; } while (0)
#define A16_V2(BF, i) do {   \
        A16_VG(BF, (i) + 1, yb0, yb1); A16_LW(2); A16_VM(i, ya0, ya1); \
        if ((i) + 2 < 32) { A16_VG(BF, (i) + 2, ya0, ya1); A16_LW(2); } else A16_LW(0); A16_VM((i) + 1, yb0, yb1); } while (0)
#define A16_STEP(t, BF, FIRST) do { \
        if (__builtin_expect(!__all(l_reg[0] < PBIG && l_reg[1] < PBIG), 0)) {     \
            float al[2]; _Pragma("unroll") for (int qb = 0; qb < 2; ++qb) { float lm = l_reg[qb]; A16_ROWRED(lm, fmaxf); const float dl = lm > 1.f ? __builtin_amdgcn_logf(lm) : 0.f; al[qb] = __builtin_amdgcn_exp2f(-dl); l_reg[qb] *= al[qb]; mref[qb] -= dl; } \
            const int lr_ = mk_lane(), fr_ = lr_ & 15, fq_ = lr_ >> 4; if (fq_ == 0) { al_l[fr_] = al[0]; al_l[16 + fr_] = al[1]; } asm volatile("s_waitcnt lgkmcnt(0)" ::: "memory"); \
            _Pragma("unroll") for (int qb = 0; qb < 2; ++qb) _Pragma("unroll") for (int r = 0; r < 4; ++r) { const float a_ = al_l[16 * qb + 4 * fq_ + r]; _Pragma("unroll") for (int vb = 0; vb < 16; ++vb) o[qb][vb][r] *= a_; } } \
        f32x4 s[2][4]; bf16x8 xa0, xa1, xb0, xb1, xc0, xc1; float ps[2] = {0.f, 0.f};     \
        A16_KG(BF, 0, xa0, xa1); A16_KG(BF, 2, xb0, xb1); \
        A16_KG(BF, 4, xc0, xc1); A16_LW(4); A16_KM0(0, xa0, xa1); A16_KG(BF, 6, xa0, xa1); A16_LW(4); A16_KM(2, xb0, xb1); A16_KG(BF, 1, xb0, xb1); A16_LW(4); A16_KM(4, xc0, xc1); A16_KG(BF, 3, xc0, xc1); A16_LW(4); A16_KM(6, xa0, xa1);     \
        if ((t) * KVBLK + KVBLK - 1 > qlo) { const int lm_ = mk_lane(); _Pragma("unroll") for (int qb = 0; qb < 2; ++qb) { const int dq = qlo + 16 * qb + (lm_ & 15) - (t) * KVBLK - 4 * (lm_ >> 4); \
                _Pragma("unroll") for (int kb = 0; kb < 2; ++kb) _Pragma("unroll") for (int r = 0; r < 4; ++r) s[qb][kb][r] = (16 * kb + r > dq) ? -__builtin_inff() : s[qb][kb][r]; } } \
        A16_KG(BF, 5, xa0, xa1); A16_LW(4); A16_KM0(1, xb0, xb1); if (!(FIRST)) { A16_E1(0); A16_E1(1); A16_E1(2); A16_E1(3); }     \
        A16_KG(BF, 7, xb0, xb1); A16_LW(4); A16_KM(3, xc0, xc1); if (!(FIRST)) { A16_E1(4); A16_E1(5); A16_E1(6); A16_E1(7); }     \
        A16_LW(2); A16_KM(5, xa0, xa1); if (!(FIRST)) { A16_E1(8); A16_E1(9); A16_E1(10); A16_E1(11); }     \
        A16_LW(0); A16_KM(7, xb0, xb1); if (!(FIRST)) { A16_E1(12); A16_E1(13); A16_E1(14); A16_E1(15); }     \
        SBAR(); if ((t) + 1 < NT) A16_DMA(((t) + 1) * KVBLK, 1 - (BF)); SBAR(); \
        if ((t) * KVBLK + KVBLK - 1 > qlo) { const int lm_ = mk_lane(); _Pragma("unroll") for (int qb = 0; qb < 2; ++qb) { const int dq = qlo + 16 * qb + (lm_ & 15) - (t) * KVBLK - 4 * (lm_ >> 4); \
                _Pragma("unroll") for (int kb = 2; kb < 4; ++kb) _Pragma("unroll") for (int r = 0; r < 4; ++r) s[qb][kb][r] = (16 * kb + r > dq) ? -__builtin_inff() : s[qb][kb][r]; } } \
        if (FIRST) { _Pragma("unroll") for (int qb = 0; qb < 2; ++qb) {              \
                float pmax = s[qb][0][0]; _Pragma("unroll") for (int kb = 0; kb < 4; ++kb) _Pragma("unroll") for (int r = 0; r < 4; ++r) pmax = fmaxf(pmax, s[qb][kb][r]); \
                A16_ROWRED(pmax, fmaxf); \
                _Pragma("unroll") for (int kb = 0; kb < 4; ++kb) s[qb][kb] -= pmax; mref[qb] -= pmax; } \
            A16_E1(0); A16_E1(1); A16_E1(2); A16_E1(3); A16_E1(4); A16_E1(5); A16_E1(6); A16_E1(7); A16_E1(8); A16_E1(9); A16_E1(10); A16_E1(11); A16_E1(12); A16_E1(13); A16_E1(14); A16_E1(15); } \
        bf16x8 pa[2][2]; \
        _Pragma("unroll") for (int qb = 0; qb < 2; ++qb) { \
            _Pragma("unroll") for (int kb = 2; kb < 4; ++kb) _Pragma("unroll") for (int r = 0; r < 4; ++r) { s[qb][kb][r] = __builtin_amdgcn_exp2f(s[qb][kb][r]); ps[qb] += s[qb][kb][r]; } \
            l_reg[qb] += ps[qb];                                                    \
            _Pragma("unroll") for (int st = 0; st < 2; ++st) { u32x4 w = {cvtpk(s[qb][2 * st][0], s[qb][2 * st][1]), cvtpk(s[qb][2 * st][2], s[qb][2 * st][3]), cvtpk(s[qb][2 * st + 1][0], s[qb][2 * st + 1][1]), cvtpk(s[qb][2 * st + 1][2], s[qb][2 * st + 1][3])}; \
                pa[qb][st] = *reinterpret_cast<bf16x8*>(&w); } } \
        { s16x4 ya0, ya1, yb0, yb1, yc0, yc1; SBAR();     \
          A16_VG(BF, 0, ya0, ya1); A16_VG(BF, 1, yb0, yb1); \
          A16_VG(BF, 2, yc0, yc1); A16_LW(4); A16_VM(0, ya0, ya1); A16_VG(BF, 3, ya0, ya1); A16_LW(4); A16_VM(1, yb0, yb1); A16_VG(BF, 4, yb0, yb1); A16_LW(4); A16_VM(2, yc0, yc1); A16_VG(BF, 5, yc0, yc1); A16_LW(4); A16_VM(3, ya0, ya1); \
          A16_VG(BF, 6, ya0, ya1); A16_LW(4); A16_VM(4, yb0, yb1); A16_VG(BF, 7, yb0, yb1); A16_LW(4); A16_VM(5, yc0, yc1); A16_VG(BF, 8, yc0, yc1); A16_LW(4); A16_VM(6, ya0, ya1); A16_VG(BF, 9, ya0, ya1); A16_LW(4); A16_VM(7, yb0, yb1); \
          A16_VG(BF, 10, yb0, yb1); A16_LW(4); A16_VM(8, yc0, yc1); A16_VG(BF, 11, yc0, yc1); A16_LW(4); A16_VM(9, ya0, ya1); A16_VG(BF, 12, ya0, ya1); A16_LW(4); A16_VM(10, yb0, yb1); A16_VG(BF, 13, yb0, yb1); A16_LW(4); A16_VM(11, yc0, yc1); \
          A16_VG(BF, 14, yc0, yc1); A16_LW(4); A16_VM(12, ya0, ya1); A16_VG(BF, 15, ya0, ya1); A16_LW(4); A16_VM(13, yb0, yb1); A16_VG(BF, 16, yb0, yb1); A16_LW(4); A16_VM(14, yc0, yc1); A16_VG(BF, 17, yc0, yc1); A16_LW(4); A16_VM(15, ya0, ya1); \
          A16_VG(BF, 18, ya0, ya1); A16_LW(4); A16_VM(16, yb0, yb1); A16_VG(BF, 19, yb0, yb1); A16_LW(4); A16_VM(17, yc0, yc1); A16_VG(BF, 20, yc0, yc1); A16_LW(4); A16_VM(18, ya0, ya1); A16_VG(BF, 21, ya0, ya1); A16_LW(4); A16_VM(19, yb0, yb1); \
          A16_VG(BF, 22, yb0, yb1); A16_LW(4); A16_VM(20, yc0, yc1); A16_VG(BF, 23, yc0, yc1); A16_LW(4); A16_VM(21, ya0, ya1); A16_VG(BF, 24, ya0, ya1); A16_LW(4); A16_VM(22, yb0, yb1); A16_VG(BF, 25, yb0, yb1); A16_LW(4); A16_VM(23, yc0, yc1); \
          A16_VG(BF, 26, yc0, yc1); A16_LW(4); A16_VM(24, ya0, ya1); A16_VG(BF, 27, ya0, ya1); A16_LW(4); A16_VM(25, yb0, yb1); A16_VG(BF, 28, yb0, yb1); A16_LW(4); A16_VM(26, yc0, yc1); A16_VG(BF, 29, yc0, yc1); A16_LW(4); A16_VM(27, ya0, ya1); \
          A16_VG(BF, 30, ya0, ya1); A16_LW(4); A16_VM(28, yb0, yb1); A16_VG(BF, 31, yb0, yb1); A16_LW(4); A16_VM(29, yc0, yc1); A16_LW(2); A16_VM(30, ya0, ya1); A16_LW(0); A16_VM(31, yb0, yb1); } \
        asm volatile("s_waitcnt vmcnt(0)" ::: "memory"); __syncthreads(); } while (0)
    for (int t = 0; t < NT; t += 2) { A16_STEP(t, 0, (t) == 0); A16_STEP(t + 1, 1, false); }
#undef A16_STEP
#undef A16_V2
#undef A16_E1
#undef A16_VM
#undef A16_VG
#undef A16_VOFFS
#undef A16_KM
#undef A16_KM0
#undef A16_KG
#undef A16_KOFFS
#undef A16_LW
#undef A16_VRD
#undef A16_KRD
#undef A16_DMA
    const int le = mk_lane(), fre = le & 15, fqe = le >> 4;
    A16_ROWRED(l_reg[0], A16_FADD); A16_ROWRED(l_reg[1], A16_FADD);
    if (fqe == 0) { li_l[fre] = l_reg[0]; li_l[16 + fre] = l_reg[1]; } asm volatile("s_waitcnt lgkmcnt(0)" ::: "memory");
#pragma unroll
    for (int qb = 0; qb < 2; ++qb)
#pragma unroll
        for (int r = 0; r < 4; ++r) { const float rl = __builtin_amdgcn_rcpf(li_l[16 * qb + 4 * fqe + r]);
#pragma unroll
            for (int vb = 0; vb < 16; ++vb) o[qb][vb][r] *= rl; }
    u32x4* Xw = (u32x4*)cur.X + (size_t)wid * (16 * 64) + le;
    if (MODE == 0) {
#pragma unroll
        for (int qb = 0; qb < 2; ++qb)
#pragma unroll
            for (int v2 = 0; v2 < 8; ++v2) { u32x4 w = {cvtpk(o[qb][2 * v2][0], o[qb][2 * v2][1]), cvtpk(o[qb][2 * v2][2], o[qb][2 * v2][3]), cvtpk(o[qb][2 * v2 + 1][0], o[qb][2 * v2 + 1][1]), cvtpk(o[qb][2 * v2 + 1][2], o[qb][2 * v2 + 1][3])};
                Xw[(qb * 8 + v2) * 64] = w; }
    } else {
        const float lam = cur.lam;
#pragma unroll
        for (int qb = 0; qb < 2; ++qb)
#pragma unroll
            for (int v2 = 0; v2 < 8; ++v2) { const u32x4 a = Xw[(qb * 8 + v2) * 64];
#pragma unroll
                for (int e = 0; e < 4; ++e) { const unsigned w = a[e]; const int vb = 2 * v2 + (e >> 1), r0 = 2 * (e & 1);
                    o[qb][vb][r0] = __builtin_bit_cast(float, w << 16) - lam * o[qb][vb][r0]; o[qb][vb][r0 + 1] = __builtin_bit_cast(float, w & 0xffff0000u) - lam * o[qb][vb][r0 + 1]; } }
#pragma unroll
        for (int qb = 0; qb < 2; ++qb)
#pragma unroll
            for (int r = 0; r < 4; ++r) { float ss = 0.f;
#pragma unroll
                for (int vb = 0; vb < 16; ++vb) ss += o[qb][vb][r] * o[qb][vb][r];
#pragma unroll
                for (int k_ = 1; k_ < 16; k_ <<= 1) ss += __builtin_bit_cast(float, __builtin_amdgcn_ds_bpermute((le ^ k_) << 2, __builtin_bit_cast(int, ss)));
                const float rs_ = __builtin_amdgcn_rsqf(ss * (1.0f / 256.0f) + 1e-5f);
#pragma unroll
                for (int vb = 0; vb < 16; ++vb) o[qb][vb][r] *= rs_; }
        char* stg = lds_g + wid * (32 * 136 * 2);
#pragma unroll
        for (int hf = 0; hf < 2; ++hf) {
#pragma unroll
            for (int qb = 0; qb < 2; ++qb)
#pragma unroll
                for (int r = 0; r < 4; ++r)
#pragma unroll
                    for (int v8 = 0; v8 < 8; ++v8) { const float v = o[qb][8 * hf + v8][r]; unsigned u_ = __builtin_bit_cast(unsigned, v);
                        *(unsigned short*)(stg + ((16 * qb + 4 * fqe + r) * 136 + 16 * v8 + fre) * 2) = (unsigned short)((u_ + 0x7fffu + ((u_ >> 16) & 1u)) >> 16); }
            asm volatile("" ::: "memory");
#pragma unroll
            for (int j = 0; j < 8; ++j) { const int row = 4 * j + (le >> 4), ch = le & 15; const u32x4 w = *(const u32x4*)(stg + (row * 136 + ch * 8) * 2);
                MK_STWT16((u32x4*)(cur.RA + (size_t)(wid * QBLK + row) * 4096 + hf * 128 + ch * 8), w, cur.wt); }
            asm volatile("" ::: "memory");
        }
        __syncthreads();
    }
}
#undef A16_ROWRED
#undef A16_FADD
}
constexpr int NWAVES = 8;
#ifndef MK_N_LAUNCHES
#define MK_N_LAUNCHES 1
#endif
constexpr int NPH = 17;
#ifndef MK_SP2
#define MK_SP2 true
#endif
#ifndef MK_ALIGN
#define MK_ALIGN true
#endif
#ifndef MK_EXTRA_BARRIERS
#define MK_EXTRA_BARRIERS 0
#endif
#ifndef MK_REPEAT_BARRIER
#define MK_REPEAT_BARRIER 0
#endif
#ifndef MK_NSTAT
#define MK_NSTAT 0
#endif
#ifndef MK_PROBE_COLDW
#define MK_PROBE_COLDW 0
#endif
#ifndef MK_FFN_SPLIT
#define MK_FFN_SPLIT 1
#endif
#ifndef MK_KVQ_SPLIT
#define MK_KVQ_SPLIT 0
#endif
#ifndef MK_REPEAT_MASK
#define MK_REPEAT_MASK 0
#endif
#ifndef MK_PHASE_MASK
#define MK_PHASE_MASK 0x1ffff
#endif
constexpr int N_LAUNCHES = MK_N_LAUNCHES;
constexpr int BATCH = 2, T = 8192, D = 4096, M = BATCH * T, FF = 11008;
constexpr size_t MiB = 1u << 20;
constexpr size_t WS_CTL = 0, CTL_ZERO_BYTES = 1 * MiB;
constexpr size_t WS_COS = 1 * MiB, WS_SIN = 5 * MiB, WS_PS = 9 * MiB, WS_RS = 13 * MiB;
constexpr size_t WS_WIN = 16 * MiB, WS_WRO = 144 * MiB, WS_WKVQ = 176 * MiB, WS_WDO = 272 * MiB, WS_WGU = 304 * MiB, WS_WDN = 648 * MiB;
constexpr size_t WS_XN = 820 * MiB, WS_RA = 948 * MiB, WS_Y = 1076 * MiB, WS_A = 1204 * MiB, WS_B = 1716 * MiB, WS_END = 2228 * MiB;
constexpr size_t WGU_BYTES = (size_t)2 * FF * D * 2, WDN_BYTES = (size_t)D * FF * 2;
constexpr int CW_BAR = 4096;
constexpr int LDS_BYTES = 147456, MISC_OFF = 139264;

#define GAS __attribute__((address_space(1)))
#define LAS __attribute__((address_space(3)))
typedef unsigned short bf16;
typedef unsigned v4u __attribute__((ext_vector_type(4)));
typedef unsigned v2u __attribute__((ext_vector_type(2)));
typedef float f32x4 __attribute__((ext_vector_type(4)));
typedef float f32x16 __attribute__((ext_vector_type(16)));
typedef short bf16x8 __attribute__((ext_vector_type(8)));
typedef short s16x4 __attribute__((ext_vector_type(4)));
#define LDS_WAIT() asm volatile("s_waitcnt lgkmcnt(0)" ::: "memory")
__device__ __forceinline__ unsigned f2bf(float f) { unsigned u = __builtin_bit_cast(unsigned, f); return (u + 0x7fffu + ((u >> 16) & 1u)) >> 16; }
__device__ __forceinline__ unsigned pk2(float lo, float hi) { return pg8::cvt_pk_bf16(lo, hi); }
__device__ __forceinline__ float bf_lo(unsigned w) { return __builtin_bit_cast(float, w << 16); }
__device__ __forceinline__ float bf_hi(unsigned w) { return __builtin_bit_cast(float, w & 0xffff0000u); }
__device__ __forceinline__ float wave_sum(float v) {
#pragma unroll
    for (int o = 1; o < 64; o <<= 1) v += __shfl_xor(v, o);
    return v;
}
#define XB_TMO      128
#define XB_XCNT(j)  (256  + 64 * (j))
#define XB_XSUB(j)  (1280 + 64 * (j))
#define XB_XGEN(j)  (2304 + 64 * (j))
#define XB_TOP      3328
#define XB_TOPGEN   3392
#define XCD_BAR_WORDS 3456
#define XB_SPIN_CAP (1u << 18)

__device__ __forceinline__ unsigned xb_ld(unsigned* p)              { return __hip_atomic_load(p, __ATOMIC_RELAXED, __HIP_MEMORY_SCOPE_AGENT); }
__device__ __forceinline__ unsigned xb_add(unsigned* p, unsigned v) { return __hip_atomic_fetch_add(p, v, __ATOMIC_RELAXED, __HIP_MEMORY_SCOPE_AGENT); }
__device__ __forceinline__ unsigned xb_xcc_id() { return (unsigned)__builtin_amdgcn_s_getreg((3 << 11) | 20) & 0xFu; }
#define XB_SPIN(cond, bar) do { unsigned _sp = 0; while (cond) { __builtin_amdgcn_s_sleep(1); \
    if ((++_sp & 255u) == 0u) { if (xb_ld(&(bar)[XB_TMO])) break; if (_sp > XB_SPIN_CAP) { atomicAdd(&(bar)[XB_TMO], 1u); break; } } } } while (0)

struct XcdBarrier {
    unsigned* bar; unsigned x;
    volatile LAS unsigned* st;
};

__device__ __forceinline__ XcdBarrier xcd_barrier_post(unsigned* bar, volatile LAS unsigned* st, bool is_t0  ) {
    XcdBarrier b; b.bar = bar; b.x = xb_xcc_id(); b.st = st;
    if (is_t0) (void)xb_add(&bar[XB_XCNT(b.x)], 1u);
    return b;
}
__device__ __forceinline__ void xcd_barrier_complete(unsigned* bar, unsigned x, unsigned& nloc, unsigned& nx) {
    const unsigned G = gridDim.x * gridDim.y * gridDim.z;
    unsigned sum, cnt, mine, sp = 0u;
    for (;;) {
        sum = 0u; cnt = 0u; mine = 0u;
#pragma unroll
        for (unsigned j = 0; j < 16; ++j) { const unsigned c = xb_ld(&bar[XB_XCNT(j)]); sum += c; cnt += (c > 0u) ? 1u : 0u; mine = (j == x) ? c : mine; }
        if (sum == G) break;
        __builtin_amdgcn_s_sleep(1);
        if ((++sp & 255u) == 0u) { if (xb_ld(&bar[XB_TMO])) break; if (sp > XB_SPIN_CAP) { atomicAdd(&bar[XB_TMO], 1u); break; } }
    }
    nloc = mine > 0u ? mine : 1u; nx = cnt > 0u ? cnt : 1u;
}

__device__ __forceinline__ void xcd_barrier(const XcdBarrier& b, bool is_t0) {
    asm volatile("s_waitcnt vmcnt(0)" ::: "memory");
    __syncthreads();
    if (is_t0) {
        unsigned* bar = b.bar;
        __builtin_amdgcn_s_waitcnt(0);
        unsigned nloc = b.st[0], nx = b.st[1];
        if (nloc == 0u) { xcd_barrier_complete(bar, b.x, nloc, nx); b.st[0] = nloc; b.st[1] = nx; }
        const unsigned old = xb_add(&bar[XB_XSUB(b.x)], 1u);
        const unsigned gen = old / nloc;
        if (old + 1u == (gen + 1u) * nloc) {
            __builtin_amdgcn_fence(__ATOMIC_RELEASE, "agent");
            asm volatile("s_waitcnt vmcnt(0)" ::: "memory");
            const unsigned og = xb_add(&bar[XB_TOP], 1u);
            const unsigned tg = og / nx;
            if (og + 1u == (tg + 1u) * nx) xb_add(&bar[XB_TOPGEN], 1u);
            else XB_SPIN(xb_ld(&bar[XB_TOPGEN]) == tg, bar);
            __builtin_amdgcn_fence(__ATOMIC_ACQUIRE, "agent");
            xb_add(&bar[XB_XGEN(b.x)], 1u);
            asm volatile("s_waitcnt vmcnt(0)" ::: "memory");
        } else {
            XB_SPIN(xb_ld(&bar[XB_XGEN(b.x)]) == gen, bar);
            __builtin_amdgcn_fence(__ATOMIC_ACQUIRE, "agent");
            asm volatile("s_waitcnt vmcnt(0)" ::: "memory");
        }
    }
    __syncthreads();
}
struct Args { const float* in[17]; float* out; unsigned char* ws; int ph_lo, ph_hi; float l2g[16]; float invf[128]; float lam_init, one_m_lam; };

__device__ __forceinline__ void transpose_item(const float* W, int K, int N, bf16* WT, int dst_row0, int dst_row1, const float* gain, int gmask, float gscale, LAS float* scr, int k0, int n0, int lane) {
    float v[64];
#pragma unroll
    for (int i = 0; i < 64; ++i) v[i] = __builtin_nontemporal_load(W + (size_t)(k0 + i) * N + n0 + lane);
#pragma unroll
    for (int i = 0; i < 64; ++i) scr[i * 65 + lane] = v[i];
    LDS_WAIT(); asm volatile("" ::: "memory");
    const int c = lane & 7;
    float g[8];
#pragma unroll
    for (int e = 0; e < 8; ++e) g[e] = gain ? gain[(k0 + 8 * c + e) & gmask] * gscale : 1.0f;
#pragma unroll
    for (int j = 0; j < 8; ++j) { const int n = (lane >> 3) + 8 * j; const LAS float* s = scr + (8 * c) * 65 + n;
        v4u o; o.x = pk2(s[0 * 65] * g[0], s[1 * 65] * g[1]); o.y = pk2(s[2 * 65] * g[2], s[3 * 65] * g[3]); o.z = pk2(s[4 * 65] * g[4], s[5 * 65] * g[5]); o.w = pk2(s[6 * 65] * g[6], s[7 * 65] * g[7]);
        const int dr = (n < 32 ? dst_row0 : dst_row1 - 32) + n;
        if (MK_BTILED) *(v4u*)(WT + (((size_t)(dr >> 8) * (K >> 6) + (k0 >> 6)) * 256 + (dr & 255)) * 64 + 8 * c) = o;
        else *(v4u*)(WT + (size_t)dr * K + k0 + 8 * c) = o; }
    LDS_WAIT(); asm volatile("" ::: "memory");
}
__device__ __forceinline__ int transpose_dst(int n0, int row_off, int mode) {
    if (mode == 1) { const int sel = n0 >= FF ? 1 : 0, j = n0 - sel * FF; return 256 * (j >> 7) + 128 * sel + (j & 127); }
    return row_off + n0;
}
__device__ __forceinline__ void transpose_job(const float* W, int K, int N, bf16* WT, int row_off, int mode, const float* gain, int gmask, float gscale, LAS float* scr, int gw, int NGW, int lane) {
    const int nblk = N / 64, nitems = (K / 64) * nblk;
    for (int it = gw; it < nitems; it += NGW) { const int kb = it / nblk, nb = it - kb * nblk, n0 = 64 * nb;
        transpose_item(W, K, N, WT, transpose_dst(n0, row_off, mode), transpose_dst(n0 + 32, row_off, mode), gain, gmask, gscale, scr, 64 * kb, n0, lane); }
}
__device__ __forceinline__ void rms_row_to_bf16(const float* xrow, bf16* orow, float* rsp, int lane, bool wtl) {
    const f32x4* xr = (const f32x4*)xrow + lane;
    f32x4 v[16]; float s = 0.f;
#pragma unroll
    for (int j = 0; j < 16; ++j) { v[j] = xr[64 * j]; s += (v[j].x * v[j].x + v[j].y * v[j].y) + (v[j].z * v[j].z + v[j].w * v[j].w); }
    const float rstd = 1.0f / sqrtf(wave_sum(s) * (1.0f / D) + 1e-6f);
    v2u* o8 = (v2u*)orow + lane;
#pragma unroll
    for (int j = 0; j < 16; ++j) { v2u w; w.x = pk2(v[j].x * rstd, v[j].y * rstd); w.y = pk2(v[j].z * rstd, v[j].w * rstd); MK_STWT8(o8 + 64 * j, w, wtl); }
    if (lane == 0) *rsp = rstd;
}
template <int MODE> __device__ __forceinline__ void norm_res_rows(const bf16* Yb, const float* PSb, const float* xin, bf16* HBb, const float* gpost, float* RSb, float* outb, int gw, int NGW, int lane) {
    f32x4 g[16];
#pragma unroll
    for (int j = 0; j < 16; ++j) g[j] = ((const f32x4*)gpost + lane)[64 * j];
    for (int m = gw; m < M; m += NGW) {
        const float rstd = 1.0f / sqrtf(wave_sum(PSb[(size_t)m * 64 + lane]) * (1.0f / D) + 1e-6f);
        const v2u* yr = (const v2u*)(Yb + (size_t)m * D) + lane; v2u* hr = (v2u*)(HBb + (size_t)m * D) + lane;
        const float hsc = MODE == 0 ? 1.0f / RSb[m] : 1.0f;
        const bool wtl = m + 2 * NGW >= M;
        f32x4 v[16]; float s = 0.f;
#pragma unroll
        for (int j = 0; j < 16; ++j) { const v2u y = yr[64 * j]; f32x4 h;
            { const v2u hh = hr[64 * j]; h.x = bf_lo(hh.x) * hsc; h.y = bf_hi(hh.x) * hsc; h.z = bf_lo(hh.y) * hsc; h.w = bf_hi(hh.y) * hsc; }
            h.x += bf_lo(y.x) * rstd * g[j].x; h.y += bf_hi(y.x) * rstd * g[j].y; h.z += bf_lo(y.y) * rstd * g[j].z; h.w += bf_hi(y.y) * rstd * g[j].w;
            v[j] = h; s += (h.x * h.x + h.y * h.y) + (h.z * h.z + h.w * h.w); }
        if (MODE == 2) {
#pragma unroll
            for (int j = 0; j < 16; ++j) ((f32x4*)(outb + (size_t)m * D) + lane)[64 * j] = v[j];
        } else {
#pragma unroll
            for (int j = 0; j < 16; ++j) { v2u w; w.x = pk2(v[j].x, v[j].y); w.y = pk2(v[j].z, v[j].w); MK_STWT8(hr + 64 * j, w, wtl); }
            const float r2 = 1.0f / sqrtf(wave_sum(s) * (1.0f / D) + 1e-6f); if (lane == 0) RSb[m] = r2; }
    }
}
__device__ __forceinline__ s16x4 tr4(LAS unsigned char* p) { return __builtin_amdgcn_ds_read_tr16_b64_v4i16((LAS s16x4*)p); }
__device__ __forceinline__ bf16x8 cat8(s16x4 a, s16x4 b) { return (bf16x8){a[0], a[1], a[2], a[3], b[0], b[1], b[2], b[3]}; }
constexpr int R12_KS = 136, R12_VS = 72, R12_KB = 128 * R12_KS * 2, R12_VB = 128 * R12_VS * 2, R12_BUF = R12_KB + R12_VB;
static_assert(2 * R12_BUF + 2 * 16384 <= MISC_OFF, "state-phase LDS map");
__device__ __forceinline__ void ret_state_phase(LAS unsigned char* lds, const bf16* Kg, const bf16* Vg, bf16* ST, const float (&l2gtab)[16], int G, int blk, int tid) {
    const int wid = __builtin_amdgcn_readfirstlane(tid >> 6), lane = tid & 63, wk = wid & 3, wv = wid >> 2, l31 = lane & 31, hh = lane >> 5;
    const int q = (lane & 15) >> 2, p = lane & 3, b16 = (lane >> 4) & 1;
    const int ka_off = ((8 * hh + q) * R12_KS + 32 * wk + 16 * b16 + 4 * p) * 2, vb_off = ((8 * hh + q) * R12_VS + 32 * wv + 16 * b16 + 4 * p) * 2;
    for (int u0 = blk; u0 < 256; u0 += G) {
        const int u = (((u0 & 7) * 4 + ((u0 >> 3) >> 3)) << 3) | ((u0 >> 3) & 7);
        const int bh = u >> 3, b = bh >> 4, h = bh & 15, vq = (u >> 1) & 3, kh = u & 1;
        const float l2g = l2gtab[h], cd = __builtin_amdgcn_exp2f(l2g * 128.0f);
        const bf16* Kp = Kg + ((size_t)b * 8192) * 4096 + h * 256 + kh * 128 + (size_t)(tid >> 4) * 4096 + (tid & 15) * 8;
        const bf16* Vp = Vg + ((size_t)b * 8192) * 4096 + h * 256 + vq * 64 + (size_t)(tid >> 3) * 4096 + (tid & 7) * 8;
        bf16* Sb = ST + ((size_t)bh * 64) * 65536 + (size_t)(vq * 64) * 256 + kh * 128;
        v4u krA[4], vrA[2], krB[4], vrB[2];
#define R12_LOAD(kr, vr, cc) do { _Pragma("unroll") for (int j = 0; j < 4; ++j) kr[j] = *(const v4u*)(Kp + (size_t)((cc) * 128 + 32 * j) * 4096); \
        _Pragma("unroll") for (int j = 0; j < 2; ++j) vr[j] = *(const v4u*)(Vp + (size_t)((cc) * 128 + 64 * j) * 4096); } while (0)
        R12_LOAD(krA, vrA, 0); R12_LOAD(krB, vrB, 1);
        f32x16 acc;
#pragma unroll
        for (int r = 0; r < 16; ++r) acc[r] = 0.f;
#define R12_STEP(kr, vr, c) do { \
            LAS unsigned char* Kb = lds + ((c) & 1) * R12_BUF; LAS unsigned char* Vb = Kb + R12_KB; \
            _Pragma("unroll") for (int j = 0; j < 4; ++j) *(LAS v4u*)(Kb + (((tid >> 4) + 32 * j) * R12_KS + (tid & 15) * 8) * 2) = kr[j]; \
            _Pragma("unroll") for (int j = 0; j < 2; ++j) { const int row = (tid >> 3) + 64 * j; const float dec = __builtin_amdgcn_exp2f(l2g * (float)(127 - row)); const v4u x = vr[j]; v4u w; \
                w.x = pk2(bf_lo(x.x) * dec, bf_hi(x.x) * dec); w.y = pk2(bf_lo(x.y) * dec, bf_hi(x.y) * dec); w.z = pk2(bf_lo(x.z) * dec, bf_hi(x.z) * dec); w.w = pk2(bf_lo(x.w) * dec, bf_hi(x.w) * dec); \
                *(LAS v4u*)(Vb + (row * R12_VS + (tid & 7) * 8) * 2) = w; } \
            if ((c) + 2 < 64) R12_LOAD(kr, vr, (c) + 2); \
              \
            { LAS unsigned char* Tb = lds + 2 * R12_BUF + ((c) & 1) * 16384; const int vl = 32 * wv + l31; \
              _Pragma("unroll") for (int g = 0; g < 4; ++g) { const int k0 = 32 * wk + 8 * g + 4 * hh; v2u w; w.x = pk2(acc[4 * g], acc[4 * g + 1]); w.y = pk2(acc[4 * g + 2], acc[4 * g + 3]); \
                  *(LAS v2u*)(Tb + vl * 256 + (((k0 >> 3) ^ (vl & 15)) << 4) + ((k0 & 4) << 1)) = w; } \
              __syncthreads(); \
              _Pragma("unroll") for (int j = 0; j < 2; ++j) { const int ci = tid + 512 * j, row = ci >> 4, ch = ci & 15; const v4u w = *(const LAS v4u*)(Tb + row * 256 + ((ch ^ (row & 15)) << 4)); \
                  *(v4u*)(Sb + (size_t)(c) * 65536 + (size_t)row * 256 + ch * 8) = w; } } \
            _Pragma("unroll") for (int r = 0; r < 16; ++r) acc[r] *= cd; \
            _Pragma("unroll") for (int ts = 0; ts < 8; ++ts) { \
                const bf16x8 a = cat8(tr4(Kb + ka_off + (16 * ts) * R12_KS * 2), tr4(Kb + ka_off + (16 * ts + 4) * R12_KS * 2)); \
                const bf16x8 bb = cat8(tr4(Vb + vb_off + (16 * ts) * R12_VS * 2), tr4(Vb + vb_off + (16 * ts + 4) * R12_VS * 2)); \
                acc = __builtin_amdgcn_mfma_f32_32x32x16_bf16(a, bb, acc, 0, 0, 0); } } while (0)
        for (int c = 0; c < 64; c += 2) { R12_STEP(krA, vrA, c); R12_STEP(krB, vrB, c + 1); }
#undef R12_STEP
#undef R12_LOAD
        __syncthreads();
    }
}
constexpr int R3_KS = 264, R3_SS = 136, R3_SOFF = 0, R3_STOFF = 8 * 16 * R3_SS * 2, R3_B1 = R3_STOFF + 64 * R3_KS * 2;
static_assert(R3_B1 >= 128 * R3_KS * 2 && R3_B1 + 128 * R3_KS * 2 <= MISC_OFF, "retention LDS map");
__device__ __forceinline__ void ret_out_phase(LAS unsigned char* lds, const bf16* Qg, const bf16* Kg, const bf16* Vg, const bf16* Gg, const bf16* ST, bf16* RA, const float (&l2gtab)[16], int G, int blk, int tid) {
    const int wid = __builtin_amdgcn_readfirstlane(tid >> 6);
    LAS unsigned char* B0 = lds; LAS unsigned char* SB = lds + R3_SOFF + wid * (16 * R3_SS * 2); LAS unsigned char* STB = lds + R3_STOFF; LAS unsigned char* B1 = lds + R3_B1;
    for (int u = blk; u < 2048; u += G) {
        int lane = tid & 63; asm volatile("" : "+v"(lane));
        const int fr = lane & 15, fq = lane >> 4, q = (lane & 15) >> 2, p = lane & 3, lrow = 2 * wid + (lane >> 5), lch = lane & 31;
        const int bh = u >> 6, c = u & 63, b = bh >> 4, h = bh & 15;
        const float l2g = l2gtab[h];
        const size_t row0 = (size_t)b * 8192 + (size_t)c * 128;
        const bf16* Qp = Qg + row0 * 4096 + h * 256; const bf16* Kp = Kg + row0 * 4096 + h * 256; const bf16* Vp = Vg + row0 * 4096 + h * 256;
        const bf16* STp = ST + ((size_t)bh * 64 + c) * 65536;
        bf16x8 qf[8];
        { v4u tk[8], tv[8];
#pragma unroll
          for (int j = 0; j < 8; ++j) tk[j] = *(const v4u*)(Kp + (size_t)(lrow + 16 * j) * 4096 + lch * 8);
#pragma unroll
          for (int j = 0; j < 8; ++j) tv[j] = *(const v4u*)(Vp + (size_t)(lrow + 16 * j) * 4096 + lch * 8);
#pragma unroll
          for (int ks = 0; ks < 8; ++ks) qf[ks] = *(const bf16x8*)(Qp + (size_t)(16 * wid + fr) * 4096 + 32 * ks + 8 * fq);
#pragma unroll
          for (int j = 0; j < 8; ++j) *(LAS v4u*)(B0 + ((lrow + 16 * j) * R3_KS + lch * 8) * 2) = tk[j];
#pragma unroll
          for (int j = 0; j < 8; ++j) *(LAS v4u*)(B1 + ((lrow + 16 * j) * R3_KS + lch * 8) * 2) = tv[j]; }
        __syncthreads();
        f32x4 s[8];
#pragma unroll
        for (int j = 0; j < 8; ++j) { s[j] = (f32x4){0.f, 0.f, 0.f, 0.f};
#pragma unroll
            for (int ks = 0; ks < 8; ++ks) { const bf16x8 kf = *(const LAS bf16x8*)(B0 + ((16 * j + fr) * R3_KS + 32 * ks + 8 * fq) * 2); s[j] = __builtin_amdgcn_mfma_f32_16x16x32_bf16(qf[ks], kf, s[j], 0, 0, 0); } }
        v4u stA[4], stB[4];
#define R3_LDST(st, qq) do { _Pragma("unroll") for (int j = 0; j < 4; ++j) st[j] = *(const v4u*)(STp + (size_t)((qq) * 64 + lrow + 16 * j) * 256 + lch * 8); } while (0)
#define R3_WRST(st) do { _Pragma("unroll") for (int j = 0; j < 4; ++j) *(LAS v4u*)(STB + ((lrow + 16 * j) * R3_KS + lch * 8) * 2) = st[j]; } while (0)
        R3_LDST(stA, 0); R3_LDST(stB, 1);
        __syncthreads();
        { int d0 = 16 * wid + 4 * fq - fr; asm volatile("" : "+v"(d0));
          const float eb = l2g * (float)d0;
#pragma unroll
          for (int j = 0; j < 8; ++j)
#pragma unroll
            for (int r = 0; r < 4; ++r) {
                const float v = s[j][r] * __builtin_amdgcn_exp2f(fmaf(l2g, (float)(r - 16 * j), eb)); unsigned sg; asm volatile("v_ashrrev_i32 %0, 31, %1" : "=v"(sg) : "v"(d0 + (r - 16 * j)));
                *(LAS unsigned short*)(SB + ((4 * fq + r) * R3_SS + 16 * j + fr) * 2) = (unsigned short)(f2bf(v) & ~sg); } }
        R3_WRST(stA);
        f32x4 o[16];
#pragma unroll
        for (int nt = 0; nt < 16; ++nt) o[nt] = (f32x4){0.f, 0.f, 0.f, 0.f};
#pragma unroll
        for (int vq = 0; vq < 4; ++vq) {
            if (vq == 0) R3_LDST(stA, 2); if (vq == 1) R3_LDST(stB, 3);
            __syncthreads();
#pragma unroll
            for (int n4 = 0; n4 < 4; ++n4)
#pragma unroll
                for (int ks = 0; ks < 8; ++ks) { const bf16x8 sf = *(const LAS bf16x8*)(STB + ((16 * n4 + fr) * R3_KS + 32 * ks + 8 * fq) * 2); o[4 * vq + n4] = __builtin_amdgcn_mfma_f32_16x16x32_bf16(qf[ks], sf, o[4 * vq + n4], 0, 0, 0); }
            if (vq < 3) { __syncthreads(); if (vq == 0) R3_WRST(stB); if (vq == 1) R3_WRST(stA); if (vq == 2) R3_WRST(stB); }
        }
#undef R3_LDST
#undef R3_WRST
        v4u g8[8];
#pragma unroll
        for (int j = 0; j < 8; ++j) g8[j] = *(const v4u*)(Gg + (row0 + 16 * wid + 2 * j + (lane >> 5)) * 4096 + h * 256 + (lane & 31) * 8);
#pragma unroll
        for (int r = 0; r < 4; ++r) { const float dq = __builtin_amdgcn_exp2f(l2g * (float)(16 * wid + 4 * fq + r + 1));
#pragma unroll
            for (int nt = 0; nt < 16; ++nt) o[nt][r] *= dq; }
#pragma unroll
        for (int ts = 0; ts < 4; ++ts) {
            { const bf16x8 sf = *(const LAS bf16x8*)(SB + (fr * R3_SS + 32 * ts + 8 * fq) * 2);
#pragma unroll
                for (int nt = 0; nt < 16; ++nt) { LAS unsigned char* vp = B1 + ((32 * ts + 8 * fq + q) * R3_KS + 16 * nt + 4 * p) * 2;
                    const bf16x8 vf = cat8(tr4(vp), tr4(vp + 4 * R3_KS * 2)); o[nt] = __builtin_amdgcn_mfma_f32_16x16x32_bf16(sf, vf, o[nt], 0, 0, 0); } } }
        __syncthreads();
        LAS unsigned char* EST = B1 + wid * (16 * R3_KS * 2);
#pragma unroll
        for (int j = 0; j < 8; ++j) *(LAS v4u*)(EST + ((2 * j + (lane >> 5)) * R3_KS + (lane & 31) * 8) * 2) = g8[j];
        asm volatile("" ::: "memory");
#pragma unroll
        for (int r = 0; r < 4; ++r) { float sm = 0.f;
#pragma unroll
            for (int nt = 0; nt < 16; ++nt) sm += o[nt][r];
            sm += __shfl_xor(sm, 1); sm += __shfl_xor(sm, 2); sm += __shfl_xor(sm, 4); sm += __shfl_xor(sm, 8);
            const float mu = sm * (1.0f / 256.0f); float vs = 0.f;
#pragma unroll
            for (int nt = 0; nt < 16; ++nt) { const float d = o[nt][r] - mu; vs += d * d; }
            vs += __shfl_xor(vs, 1); vs += __shfl_xor(vs, 2); vs += __shfl_xor(vs, 4); vs += __shfl_xor(vs, 8);
            const float rstd = 1.0f / sqrtf(vs * (1.0f / 256.0f) + 1e-5f);
            LAS unsigned short* gp = (LAS unsigned short*)(EST + ((4 * fq + r) * R3_KS + fr) * 2);
#pragma unroll
            for (int nt = 0; nt < 16; ++nt) { const float g = __builtin_bit_cast(float, (unsigned)gp[16 * nt] << 16); gp[16 * nt] = (unsigned short)f2bf((o[nt][r] - mu) * rstd * g); } }
        asm volatile("" ::: "memory");
#pragma unroll
        for (int j = 0; j < 8; ++j) { const v4u w = *(const LAS v4u*)(EST + ((2 * j + (lane >> 5)) * R3_KS + (lane & 31) * 8) * 2);
            MK_STWT16((v4u*)(RA + (row0 + 16 * wid + 2 * j + (lane >> 5)) * 4096 + h * 256 + (lane & 31) * 8), w, u + G >= 2048); }
        __syncthreads();
    }
}
#ifndef MK_ATT16
#define MK_ATT16 1
#endif
#if MK_ATT16
#define MK_ATT_BLOCK att::attn16_block
#else
#define MK_ATT_BLOCK att::attn2_block
#endif
__device__ __forceinline__ att::Ref2 att_ref2(int bh, int i, int qb, const bf16* QH, const bf16* KH, const bf16* VH, float* X, bf16* RA, float lam, int wt = 0) {
    const int hm = bh * 2 + i, b = bh >> 4, h = bh & 15;
    att::Ref2 r;
    r.Q = QH + ((size_t)hm * 8192 + (size_t)qb * 256) * 128; r.K = KH + (size_t)hm * 8192 * 128; r.V0 = VH + (size_t)(bh * 2) * 8192 * 128; r.V1 = VH + (size_t)(bh * 2 + 1) * 8192 * 128;
    r.X = X; r.RA = RA + ((size_t)b * 8192 + (size_t)qb * 256) * 4096 + h * 256; r.lam = lam; r.P0 = qb * 256; r.wt = wt;
    return r;
}
__device__ __forceinline__ void attn_phase(char* lds, const bf16* QH, const bf16* KH, const bf16* VH, float* XS, bf16* RA, const float* lamp, float lam_init, int G, int blk, int wave_id) {
    const int lane = mk_lane();
    float a = lamp[lane] * lamp[128 + lane] + lamp[64 + lane] * lamp[192 + lane], c = lamp[256 + lane] * lamp[384 + lane] + lamp[320 + lane] * lamp[448 + lane];
    const float lam = __builtin_bit_cast(float, __builtin_amdgcn_readfirstlane(__builtin_bit_cast(int, __expf(wave_sum(a)) - __expf(wave_sum(c)) + lam_init)));
    float* X = XS + (size_t)blk * (8 * 32 * 64 * 4);
    for (int L = blk; L < 512; L += G) {
        const int xcd = L & 7, k = L >> 3, bh = xcd * 4 + (k >> 4), x = k & 15;
        { const att::Ref2 cur = att_ref2(bh, 0, 31 - x, QH, KH, VH, X, RA, lam); MK_ATT_BLOCK<0>(cur, lds, wave_id); }
        { const att::Ref2 cur = att_ref2(bh, 0, x, QH, KH, VH, X + 8 * 16 * 64 * 4, RA, lam); MK_ATT_BLOCK<0>(cur, lds, wave_id); }
        { const att::Ref2 cur = att_ref2(bh, 1, 31 - x, QH, KH, VH, X, RA, lam, L + G >= 512); MK_ATT_BLOCK<1>(cur, lds, wave_id); }
        { const att::Ref2 cur = att_ref2(bh, 1, x, QH, KH, VH, X + 8 * 16 * 64 * 4, RA, lam, L + G >= 512); MK_ATT_BLOCK<1>(cur, lds, wave_id); }
    }
}
extern __shared__ __attribute__((aligned(16))) unsigned char lds_raw[];
struct Ctx { LAS unsigned char* lds; unsigned char* ws; int wave, G, blk, gw, NGW; };
template <int P> __device__ __forceinline__ void run_phase(const Ctx& c, const Args& a) {
    const int tid = c.wave * 64 + mk_lane();
    unsigned char* ws = c.ws; const int G = c.G, blk = c.blk, gw = c.gw, NGW = c.NGW, lane = tid & 63; LAS unsigned char* lds = c.lds;
    bf16* const W_in = (bf16*)(ws + WS_WIN); bf16* const W_ro = (bf16*)(ws + WS_WRO); bf16* const W_kvq = (bf16*)(ws + WS_WKVQ); bf16* const W_do = (bf16*)(ws + WS_WDO);
    bf16* const W_gu = (bf16*)(ws + WS_WGU); bf16* const W_dn = (bf16*)(ws + WS_WDN);
    bf16* const XN = (bf16*)(ws + WS_XN); bf16* const RA = (bf16*)(ws + WS_RA); bf16* const Y = (bf16*)(ws + WS_Y); float* const PS = (float*)(ws + WS_PS);
    bf16* const QKVG = (bf16*)(ws + WS_A); bf16* const KVQ = (bf16*)(ws + WS_A);
    bf16* const STT = (bf16*)(ws + WS_B); bf16* const HB = (bf16*)(ws + WS_B); float* const AO = (float*)(ws + WS_B);
    constexpr size_t TSZ = (size_t)M * 4096, HSZ = (size_t)64 * 8192 * 128;
    float* const RS = (float*)(ws + WS_RS);
    if constexpr (P == 0) {
        LAS float* scr = (LAS float*)(lds + c.wave * 16896);
        transpose_job(a.in[3], D, 4 * D, W_in, 0, 0, a.in[1], 0x7fffffff, 1.0f, scr, gw, NGW, lane);
        transpose_job(a.in[4], D, D, W_ro, 0, 0, nullptr, 0, 1.0f, scr, gw, NGW, lane);
        transpose_job(a.in[6], D, 2 * D, W_kvq, 0, 0, a.in[5], 0x7fffffff, 1.0f, scr, gw, NGW, lane);
        transpose_job(a.in[9], D, D, W_kvq, 2 * D, 0, a.in[7], 0x7fffffff, 1.4426950408889634f * att::SCALE, scr, gw, NGW, lane);
        transpose_job(a.in[12], D, D, W_do, 0, 0, a.in[11], 255, a.one_m_lam, scr, gw, NGW, lane);
        for (int l = 0; l < 2; ++l) {
            transpose_job(a.in[15] + (size_t)l * D * 2 * FF, D, 2 * FF, W_gu + (size_t)l * 2 * FF * D, 0, 1, a.in[13] + l * D, 0x7fffffff, 1.0f, scr, gw, NGW, lane);
            transpose_job(a.in[16] + (size_t)l * FF * D, FF, D, W_dn + (size_t)l * D * FF, 0, 0, nullptr, 0, 1.0f, scr, gw, NGW, lane); }
        for (int m = gw; m < M; m += NGW) rms_row_to_bf16(a.in[0] + (size_t)m * D, XN + (size_t)m * D, RS + m, lane, m + 2 * NGW >= M);
    }
    if constexpr (P == 1) {
        pg8::Gemm g{XN, W_in, M, 4 * D, D}; pg8::EpiQKVG E{QKVG};
#if MK_NSTAT
        pg8::NStatOrder S; S.init(M, 4 * D, G, blk); pg8::gemm_phase<pg8::EpiQKVG, pg8::NStatOrder, MK_ALIGN, MK_SP2>(lds, g, S, E, c.wave); }
#else
        pg8::StaticOrder S; S.init(M, 4 * D, G, blk); pg8::gemm_phase<pg8::EpiQKVG, pg8::StaticOrder, MK_ALIGN, MK_SP2>(lds, g, S, E, c.wave); }
#endif
    if constexpr (P == 2) ret_state_phase(lds, QKVG + TSZ, QKVG + 2 * TSZ, STT, a.l2g, G, blk, tid);
    if constexpr (P == 3) ret_out_phase(lds, QKVG, QKVG + TSZ, QKVG + 2 * TSZ, QKVG + 3 * TSZ, STT, RA, a.l2g, G, blk, tid);
    if constexpr (P == 4 || P == 12) { pg8::Gemm g{RA, P == 4 ? W_ro : W_do, M, D, D}; pg8::StaticOrder S; S.init(M, D, G, blk); pg8::EpiYSS E{Y, PS};
        pg8::gemm_phase<pg8::EpiYSS, pg8::StaticOrder, MK_ALIGN, MK_SP2>(lds, g, S, E, c.wave); }
    if constexpr (P == 5)  norm_res_rows<0>(Y, PS, a.in[0], XN, a.in[2], RS, nullptr, gw, NGW, lane);
    if constexpr (P == 8)  norm_res_rows<1>(Y, PS, nullptr, XN, a.in[14], RS, nullptr, gw, NGW, lane);
    if constexpr (P == 13) norm_res_rows<1>(Y, PS, nullptr, XN, a.in[8], RS, nullptr, gw, NGW, lane);
    if constexpr (P == 16) norm_res_rows<2>(Y, PS, nullptr, XN, a.in[14] + D, nullptr, a.out, gw, NGW, lane);
    constexpr bool L1 = (P == 14 || P == 15 || P == 114); constexpr int MH = MK_FFN_SPLIT ? M / 2 : M, PMH = M / 512;
    if constexpr (P == 6 || P == 14 || ((P == 7 || P == 15) && MK_FFN_SPLIT)) {
        if constexpr (P == 7 || P == 15) { pg8::Gemm g{HB, W_dn + (L1 ? (size_t)D * FF : 0), M, D, FF}; pg8::StaticOrder S; S.init(MH, D, G, blk, 0); pg8::EpiYSS E{Y, PS};
            pg8::gemm_phase<pg8::EpiYSS, pg8::StaticOrder, MK_ALIGN, MK_SP2, MK_HTILED != 0>(lds, g, S, E, c.wave); }
        pg8::Gemm g{XN, W_gu + (L1 ? (size_t)2 * FF * D : 0), M, 2 * FF, D}; pg8::StaticOrder S; S.init(MH, 2 * FF, G, blk, (P == 7 || P == 15) ? PMH : 0); pg8::EpiSwiGLU E{HB, RS};
        pg8::gemm_phase<pg8::EpiSwiGLU, pg8::StaticOrder, MK_ALIGN, MK_SP2>(lds, g, S, E, c.wave); }
    if constexpr (((P == 7 || P == 15) && !MK_FFN_SPLIT) || P == 106 || P == 114) { pg8::Gemm g{HB, W_dn + (L1 ? (size_t)D * FF : 0), M, D, FF}; pg8::StaticOrder S; S.init(MH, D, G, blk, MK_FFN_SPLIT ? PMH : 0); pg8::EpiYSS E{Y, PS};
        pg8::gemm_phase<pg8::EpiYSS, pg8::StaticOrder, MK_ALIGN, MK_SP2, MK_HTILED != 0>(lds, g, S, E, c.wave); }
    if constexpr (P == 9) { pg8::Gemm g{XN, W_kvq, M, 3 * D, D}; pg8::StaticOrder S; S.init(M, 3 * D, G, blk); pg8::EpiKVQ E{KVQ, RS};
        pg8::gemm_phase<pg8::EpiKVQ, pg8::StaticOrder, MK_ALIGN, MK_SP2>(lds, g, S, E, c.wave); }
    if constexpr (P == 10) attn_phase((char*)lds_raw, KVQ + 2 * HSZ, KVQ, KVQ + HSZ, AO, RA, a.in[10], a.lam_init, G, blk, c.wave);
}
__global__ void __launch_bounds__(NWAVES * 64, 2) mk_fwd(Args a) {
    Ctx c; c.lds = (LAS unsigned char*)lds_raw; c.ws = a.ws;
    volatile LAS unsigned* MISC = (volatile LAS unsigned*)(c.lds + MISC_OFF);
    c.wave = __builtin_amdgcn_readfirstlane((int)threadIdx.x >> 6); c.G = gridDim.x; c.blk = blockIdx.x;
    c.gw = c.blk * NWAVES + c.wave; c.NGW = c.G * NWAVES;
    for (int u = threadIdx.x; u < (LDS_BYTES - MISC_OFF) / 4; u += NWAVES * 64) ((LAS unsigned*)(c.lds + MISC_OFF))[u] = 0u;
    __syncthreads();
    XcdBarrier bar; bar.bar = (unsigned*)(a.ws + WS_CTL) + CW_BAR; bar.x = 0; bar.st = nullptr;
    if (N_LAUNCHES == 1) bar = xcd_barrier_post((unsigned*)(a.ws + WS_CTL) + CW_BAR, MISC + 8, threadIdx.x == 0);
    const int lo = a.ph_lo, hi = a.ph_hi;
#define IN(k) (((MK_PHASE_MASK >> (k)) & 1) && lo <= (k) && (k) < hi)
    static_assert(N_LAUNCHES == 1 || !MK_FFN_SPLIT, "the one-launch-per-phase bring-up build has no barrier inside a launch: build it with MK_FFN_SPLIT 0");
#define RUNX(k, kk) do { if (MK_FFN_SPLIT && IN(k)) { run_phase<kk>(c, a); if (N_LAUNCHES == 1 && IN((k) + 1)) xcd_barrier(bar, c.wave == 0 && mk_lane() == 0); } } while (0)
#define RUN(k) do { if (IN(k)) { run_phase<k>(c, a); if constexpr ((MK_REPEAT_MASK >> (k)) & 1) { if (MK_REPEAT_BARRIER) xcd_barrier(bar, c.wave == 0 && mk_lane() == 0); run_phase<k>(c, a); } } if (N_LAUNCHES == 1 && IN(k) && IN((k) + 1)) { xcd_barrier(bar, c.wave == 0 && mk_lane() == 0); for (int xb_ = 0; xb_ < MK_EXTRA_BARRIERS; ++xb_) xcd_barrier(bar, c.wave == 0 && mk_lane() == 0); } } while (0)
    RUN(0); RUN(1); RUN(2); RUN(3); RUN(4); RUN(5); RUN(6);
    RUN(7); RUNX(7, 106); RUN(8); RUN(9); RUN(10);
    RUN(12); RUN(13); RUN(14); RUN(15); RUNX(15, 114); RUN(16);
#undef IN
#undef RUN
#undef RUNX
}

extern "C" void kernel_launch(void* const* d_in, const int* in_sizes, int n_in, void* d_out, int out_size, void* d_ws, size_t ws_size, hipStream_t stream) {
    static int grid = 0;
    if (grid == 0) {
        if (n_in != 17 || out_size != M * D || ws_size < WS_END) { fprintf(stderr, "kernel_launch: unexpected problem (n_in %d, out %d, ws %zu)\n", n_in, out_size, ws_size); grid = -1; return; }
        int dev = 0, cus = 0;
        if (hipGetDevice(&dev) != hipSuccess || hipDeviceGetAttribute(&cus, hipDeviceAttributeMultiprocessorCount, dev) != hipSuccess) { grid = -1; return; }
        if (hipFuncSetAttribute((const void*)mk_fwd, hipFuncAttributeMaxDynamicSharedMemorySize, LDS_BYTES) != hipSuccess) { fprintf(stderr, "kernel_launch: hipFuncSetAttribute failed\n"); grid = -1; return; }
        int per_cu = 0;
        if (hipOccupancyMaxActiveBlocksPerMultiprocessor(&per_cu, (const void*)mk_fwd, NWAVES * 64, LDS_BYTES) != hipSuccess || per_cu < 1) fprintf(stderr, "kernel_launch: occupancy query says %d\n", per_cu);
        (void)hipGetLastError();
        grid = cus;
    }
    if (grid < 0) return;
    (void)hipMemsetAsync((char*)d_ws + WS_CTL, 0, CTL_ZERO_BYTES, stream);
    Args a{};
    for (int i = 0; i < 17; ++i) a.in[i] = (const float*)d_in[i];
    a.out = (float*)d_out; a.ws = (unsigned char*)d_ws;
    for (int h = 0; h < 16; ++h) a.l2g[h] = (float)(log1p(-exp2(-5.0 - (double)h)) / log(2.0));
    for (int j = 0; j < 128; ++j) a.invf[j] = (float)(1.0 / pow(10000.0, (double)j / 127.0));
    const double li = 0.8 - 0.6 * exp(-0.3 * 1.0);
    a.lam_init = (float)li; a.one_m_lam = (float)(1.0 - li);
    if (N_LAUNCHES == 1) { a.ph_lo = 0; a.ph_hi = NPH; hipLaunchKernelGGL(mk_fwd, dim3(grid), dim3(NWAVES * 64), LDS_BYTES, stream, a); }
    else for (int p = 0; p < NPH; ++p) { a.ph_lo = p; a.ph_hi = p + 1; hipLaunchKernelGGL(mk_fwd, dim3(grid), dim3(NWAVES * 64), LDS_BYTES, stream, a); }
}
```

```cpp
#include <hip/hip_runtime.h>
#include <cstdio>
#include <cstdint>
#include <cmath>
#ifndef MK_BTILED
#define MK_BTILED 1
#endif
#ifndef MK_HTILED
#define MK_HTILED 0
#endif
#ifndef MK_FRESH
#define MK_FRESH 1
#endif
#ifndef MK_PN_ROT
#define MK_PN_ROT 0
#endif
__device__ __forceinline__ int mk_lane() { int l; asm volatile("v_mbcnt_lo_u32_b32 %0, -1, 0\n\tv_mbcnt_hi_u32_b32 %0, -1, %0" : "=v"(l)); return l; }
namespace pg8 {
#define PG8_LAS __attribute__((address_space(3)))
typedef unsigned short bf16_t;
typedef short bf16x8 __attribute__((ext_vector_type(8)));
typedef float f32x4 __attribute__((ext_vector_type(4)));
typedef unsigned u32x4 __attribute__((ext_vector_type(4)));
constexpr int BM = 256, BK = 64, HALF = 128, HTB = HALF * BK * 2  , STAGE_BYTES = 8 * HTB, NXCD = 8, WGM = 8;

__host__ __device__ __forceinline__ int lds_byte(int r, int c) { const int st = (r >> 4) * 2 + (c >> 5), rr = r & 15, cc = c & 31, ob = rr * 64 + cc * 2; return st * 1024 + (ob ^ (((ob >> 9) & 1) << 5)); }
__host__ __device__ __forceinline__ void stage_rc(int b, int& R, int& C) { const int st = b / 1024, sb = b % 1024, swz = sb ^ (((sb >> 9) & 1) << 5); R = (st >> 1) * 16 + swz / 64; C = (st & 1) * 32 + (swz % 64) / 2; }
__host__ __device__ __forceinline__ int perm32(int rho) { const int n = rho >> 4, i = rho & 15; return 8 * (i >> 2) + 4 * n + (i & 3); }

struct Unit { int pm, pn; };
struct Gemm { const bf16_t* A; const bf16_t* Bt; int M, N, K; };

struct StaticOrder {
    int nM, nN, nwg, G, c, pm0;
    __host__ __device__ void init(int M, int N, int G_, int c_, int pm0_ = 0) { nM = M / BM; nN = N / BM; nwg = nM * nN; G = G_; c = c_; pm0 = pm0_; }
    __host__ __device__ bool next(int i, Unit& u) const {
        const long L = (long)i * G + c; if (L >= nwg) return false;
        int wgid = (int)L; { const int q = nwg / NXCD, r = nwg % NXCD, xcd = wgid % NXCD, off = wgid / NXCD; wgid = (xcd < r ? xcd * (q + 1) : r * (q + 1) + (xcd - r) * q) + off; }
        const int nig = WGM * nN, gid = wgid / nig, fm = gid * WGM, gsz = (nM - fm) < WGM ? (nM - fm) : WGM;
        u.pm = pm0 + fm + ((wgid % nig) % gsz); u.pn = (wgid % nig) / gsz;
#if MK_PN_ROT
        { int p = u.pn + (c & 7) * (nN / 8); u.pn = p >= nN ? p - nN : p; }
#endif
        return true;
    }
    __device__ __forceinline__ void a_ready(const Unit&) const {}
    __device__ __forceinline__ void done(const Unit&) const {}
};

struct NStatOrder {
    int nM, nN, G, c;
    __host__ __device__ void init(int M, int N, int G_, int c_) { nM = M / BM; nN = N / BM; G = G_; c = c_; }
    __host__ __device__ bool next(int i, Unit& u) const {
        const int x = c & 7, cc = c >> 3, per = nN >> 3, rpb = nM >> 3, nb = per >> 2;
        if (i >= nb * rpb || cc >= 32) return false;
        const int hb = i / rpb, pmb = i - hb * rpb;
        u.pm = 8 * pmb + (cc & 7); u.pn = x * per + 4 * hb + (cc >> 3); return true;
    }
    __device__ __forceinline__ void a_ready(const Unit&) const {}
    __device__ __forceinline__ void done(const Unit&) const {}
};

__device__ __forceinline__ unsigned cvt_pk_bf16(float lo, float hi) { unsigned r; asm volatile("v_cvt_pk_bf16_f32 %0, %1, %2" : "=v"(r) : "v"(lo), "v"(hi)); return r; }
typedef float f32x2 __attribute__((ext_vector_type(2)));
#ifndef MK_P1_FRESH
#define MK_P1_FRESH 1
#endif
#ifndef MK_NT_STORES
#define MK_NT_STORES 0
#endif
#if MK_NT_STORES
#define PG8_ST16(p, v) __builtin_nontemporal_store((v), (u32x4*)(p))
#else
#define PG8_ST16(p, v) (*(u32x4*)(p) = (v))
#endif
__device__ __forceinline__ float silu_f(float v) { return v * __builtin_amdgcn_rcpf(1.0f + __builtin_amdgcn_exp2f(-1.4426950408889634f * v)); }
struct EpiQKVG {
    static constexpr bool PERM = true, AFTER_DRAIN = false; static constexpr bool RS_LDS = false; static constexpr int NST = 16; static constexpr bool FRESH_OK = MK_P1_FRESH != 0;
    bf16_t* O;
    __device__ __forceinline__ void operator()(const f32x4 (&acc)[2][2][4][2], const Unit& u, int wr, int wc, int fr, int fq, const PG8_LAS float* rsl) const {
        asm volatile("" : "+v"(fr), "+v"(fq));
        const int row0 = u.pm * BM + wr * 64 + fr, t = u.pn >> 4, colt = (u.pn & 15) * BM;
        bf16_t* base = O + (size_t)t * ((size_t)16384 * 4096);
        const int col0 = colt + wc * 32 + 8 * fq;
        float ivf[2][4];
#pragma unroll
        for (int bj = 0; bj < 2; ++bj)
#pragma unroll
            for (int j = 0; j < 4; ++j) ivf[bj][j] = __builtin_amdgcn_exp2f((float)(64 * bj + 16 * wc + 4 * fq + j) * (-13.287712379549449f / 127.0f));
#pragma unroll
        for (int ai = 0; ai < 2; ++ai)
#pragma unroll
            for (int m = 0; m < 4; ++m) { const int row = row0 + ai * HALF + m * 16, pos = row & 8191; bf16_t* rowp = base + (size_t)row * 4096 + col0;
#pragma unroll
                for (int bj = 0; bj < 2; ++bj) { f32x4 v0 = acc[ai][bj][m][0], v1 = acc[ai][bj][m][1];
                    if (t < 2) { f32x4 c, s;
#pragma unroll
                        for (int j = 0; j < 4; ++j) { const float ang = (float)pos * ivf[bj][j], rev = ang * 0.15915494309189535f, frc = __builtin_amdgcn_fractf(rev); c[j] = __builtin_amdgcn_cosf(frc); s[j] = __builtin_amdgcn_sinf(frc); }
                        const float sc = (t == 1) ? 0.0625f : 1.0f;
                        f32x4 r0, r1;
                        r0[0] = (v0[0] * c[0] - v0[1] * s[0]) * sc; r0[1] = (v0[0] * s[0] + v0[1] * c[0]) * sc;
                        r0[2] = (v0[2] * c[1] - v0[3] * s[1]) * sc; r0[3] = (v0[2] * s[1] + v0[3] * c[1]) * sc;
                        r1[0] = (v1[0] * c[2] - v1[1] * s[2]) * sc; r1[1] = (v1[0] * s[2] + v1[1] * c[2]) * sc;
                        r1[2] = (v1[2] * c[3] - v1[3] * s[3]) * sc; r1[3] = (v1[2] * s[3] + v1[3] * c[3]) * sc;
                        v0 = r0; v1 = r1; }
                    else if (t == 3) {
#pragma unroll
                        for (int j = 0; j < 4; ++j) { v0[j] = silu_f(v0[j]); v1[j] = silu_f(v1[j]); } }
                    u32x4 w; w.x = cvt_pk_bf16(v0[0], v0[1]); w.y = cvt_pk_bf16(v0[2], v0[3]); w.z = cvt_pk_bf16(v1[0], v1[1]); w.w = cvt_pk_bf16(v1[2], v1[3]);
                    PG8_ST16(rowp + bj * HALF, w); } }
    }
};
struct EpiYSS {
    static constexpr bool PERM = true, AFTER_DRAIN = false, RS_LDS = false; static constexpr int NST = 16; static constexpr bool FRESH_OK = true;
    bf16_t* Y; float* PS;
    __device__ __forceinline__ void operator()(const f32x4 (&acc)[2][2][4][2], const Unit& u, int wr, int wc, int fr, int fq, const PG8_LAS float* rsl) const {
        const int row0 = u.pm * BM + wr * 64 + fr, col0 = u.pn * BM + wc * 32 + 8 * fq;
#pragma unroll
        for (int ai = 0; ai < 2; ++ai)
#pragma unroll
            for (int m = 0; m < 4; ++m) { const int row = row0 + ai * HALF + m * 16; bf16_t* rowp = Y + (size_t)row * 4096 + col0; float ss = 0.f;
#pragma unroll
                for (int bj = 0; bj < 2; ++bj) { const f32x4 v0 = acc[ai][bj][m][0], v1 = acc[ai][bj][m][1];
                    ss += (v0[0] * v0[0] + v0[1] * v0[1]) + (v0[2] * v0[2] + v0[3] * v0[3]) + (v1[0] * v1[0] + v1[1] * v1[1]) + (v1[2] * v1[2] + v1[3] * v1[3]);
                    u32x4 w; w.x = cvt_pk_bf16(v0[0], v0[1]); w.y = cvt_pk_bf16(v0[2], v0[3]); w.z = cvt_pk_bf16(v1[0], v1[1]); w.w = cvt_pk_bf16(v1[2], v1[3]);
                    PG8_ST16(rowp + bj * HALF, w); }
                ss += __shfl_xor(ss, 16); ss += __shfl_xor(ss, 32);
                if (fq == 0) PS[(size_t)row * 64 + u.pn * 4 + wc] = ss; }
    }
};
struct EpiSwiGLU {
    static constexpr bool PERM = true, AFTER_DRAIN = false, RS_LDS = true; static constexpr int NST = 8; static constexpr bool FRESH_OK = true;
    bf16_t* Hh; const float* rs;
    __device__ __forceinline__ void operator()(const f32x4 (&acc)[2][2][4][2], const Unit& u, int wr, int wc, int fr, int fq, const PG8_LAS float* rsl) const {
        const int row0 = u.pm * BM + wr * 64 + fr, col0 = u.pn * HALF + wc * 32 + 8 * fq;
#pragma unroll
        for (int ai = 0; ai < 2; ++ai)
#pragma unroll
            for (int m = 0; m < 4; ++m) { const int row = row0 + ai * HALF + m * 16; const float r1 = rsl[row & 255];
                f32x4 h0, h1;
#pragma unroll
                for (int j = 0; j < 4; ++j) { h0[j] = silu_f(acc[ai][0][m][0][j] * r1) * (acc[ai][1][m][0][j] * r1); h1[j] = silu_f(acc[ai][0][m][1][j] * r1) * (acc[ai][1][m][1][j] * r1); }
                u32x4 w; w.x = cvt_pk_bf16(h0[0], h0[1]); w.y = cvt_pk_bf16(h0[2], h0[3]); w.z = cvt_pk_bf16(h1[0], h1[1]); w.w = cvt_pk_bf16(h1[2], h1[3]);
                if (MK_HTILED) PG8_ST16(Hh + (((size_t)u.pm * 172 + (col0 >> 6)) * 256 + (row & 255)) * 64 + (col0 & 63), w);
                else PG8_ST16(Hh + (size_t)row * 11008 + col0, w);
#ifdef MK_PROBE_DUPSTORE
                PG8_ST16(Hh + (size_t)268435456 + (size_t)row * 11008 + col0, w);
#endif
                }
    }
};
struct EpiKVQ {
    static constexpr bool PERM = true, AFTER_DRAIN = false, RS_LDS = true; static constexpr int NST = 16; static constexpr bool FRESH_OK = true;
    bf16_t* O; const float* rs;
    __device__ __forceinline__ void operator()(const f32x4 (&acc)[2][2][4][2], const Unit& u, int wr, int wc, int fr, int fq, const PG8_LAS float* rsl) const {
        const int row0 = u.pm * BM + wr * 64 + fr, t = u.pn >> 4, hp = u.pn & 15;
        bf16_t* base = O + (size_t)t * ((size_t)64 * 8192 * 128) + wc * 32 + 8 * fq;
#pragma unroll
        for (int ai = 0; ai < 2; ++ai)
#pragma unroll
            for (int m = 0; m < 4; ++m) { const int row = row0 + ai * HALF + m * 16, b = row >> 13, s = row & 8191; const float r1 = rsl[row & 255];
#pragma unroll
                for (int bj = 0; bj < 2; ++bj) { const f32x4 v0 = acc[ai][bj][m][0] * r1, v1 = acc[ai][bj][m][1] * r1;
                    u32x4 w; w.x = cvt_pk_bf16(v0[0], v0[1]); w.y = cvt_pk_bf16(v0[2], v0[3]); w.z = cvt_pk_bf16(v1[0], v1[1]); w.w = cvt_pk_bf16(v1[2], v1[3]);
                    PG8_ST16(base + ((size_t)(b * 32 + 2 * hp + bj) * 8192 + s) * 128, w); } }
    }
};
template <class Epi, class Sched, bool ALIGN_EPI = false, bool SP2 = false, bool ATILED = false  >
__device__ __forceinline__ void gemm_phase(PG8_LAS unsigned char* lds, const Gemm g, const Sched& S, const Epi& E, int wave_id  ) {
    const int lane = mk_lane(), wid = wave_id, tid = wid * 64 + lane, wr = wid >> 2, wc = wid & 3, fr = lane & 15, fq = lane >> 4;
    const int K = g.K, nt = K / BK;
    unsigned voffA[2], voffB[2];
#pragma unroll
    for (int i = 0; i < 2; ++i) { int R, C; stage_rc(tid * 16 + i * 8192, R, C); const int Rb = Epi::PERM ? ((R & ~31) + perm32(R & 31)) : R;
        voffA[i] = ATILED ? (unsigned)(R * BK + C) * 2u : (unsigned)(R * K + C) * 2u; voffB[i] = MK_BTILED ? (unsigned)(Rb * BK + C) * 2u : (unsigned)(Rb * K + C) * 2u; }
    const size_t kstep = (size_t)(BK * 2);
    const size_t hstep = (size_t)HALF * K * 2;
    const size_t tstep = 2 * hstep;
    const size_t kstepA = ATILED ? (size_t)(BM * BK * 2) : kstep, hstepA = ATILED ? (size_t)(HALF * BK * 2) : hstep;
    const size_t kstepB = MK_BTILED ? (size_t)(BM * BK * 2) : kstep, hstepB = MK_BTILED ? (size_t)(HALF * BK * 2) : hstep;
    const unsigned ldsw = (unsigned)wid * 1024u;
    const int aoff = lds_byte(wr * 64 + fr, fq * 8), boff = lds_byte(wc * 32 + fr, fq * 8);
#define PG8_SA(b, h) (((b) * 2 + (h)) * HTB)
#define PG8_SB(b, h) ((4 + (b) * 2 + (h)) * HTB)
#ifndef MK_B_AUX
#define MK_B_AUX 0
#endif
#define PG8_STAGE(bufoff, gbase, voff) do { _Pragma("unroll") for (int _i = 0; _i < 2; ++_i) \
        __builtin_amdgcn_global_load_lds((const unsigned*)((const char*)(gbase) + (voff)[_i]), (PG8_LAS unsigned*)(lds + (bufoff) + ldsw + _i * 8192), 16, 0, ((bufoff) >= 4 * HTB) ? MK_B_AUX : 0); } while (0)
#define PG8_LDA(dst, b, h) do { _Pragma("unroll") for (int m = 0; m < 4; ++m) _Pragma("unroll") for (int k = 0; k < 2; ++k) dst[m][k] = *(const PG8_LAS bf16x8*)(lds + PG8_SA(b, h) + aoff + m * 2048 + k * 1024); } while (0)
#define PG8_LDB(dst, b, h) do { _Pragma("unroll") for (int n = 0; n < 2; ++n) _Pragma("unroll") for (int k = 0; k < 2; ++k) dst[n][k] = *(const PG8_LAS bf16x8*)(lds + PG8_SB(b, h) + boff + n * 2048 + k * 1024); } while (0)
#define PG8_MMA(ai, bj, At, Bt) do { __builtin_amdgcn_s_setprio(1); _Pragma("unroll") for (int m = 0; m < 4; ++m) _Pragma("unroll") for (int n = 0; n < 2; ++n) _Pragma("unroll") for (int k = 0; k < 2; ++k) \
        acc[ai][bj][m][n] = __builtin_amdgcn_mfma_f32_16x16x32_bf16(Bt[n][k], At[m][k], acc[ai][bj][m][n], 0, 0, 0); __builtin_amdgcn_s_setprio(0); } while (0)
#define PG8_WAIT_V(n) asm volatile("s_waitcnt vmcnt(" #n ")" ::: "memory")
#define PG8_WAIT_VN(n) asm volatile("s_waitcnt vmcnt(%0)" :: "i"(n) : "memory")
#define PG8_WAIT_L(n) asm volatile("s_waitcnt lgkmcnt(" #n ")" ::: "memory")
#define PG8_BAR __builtin_amdgcn_s_barrier()
#define PG8_SCHED __builtin_amdgcn_sched_barrier(0)
    Unit cur, nxt; int ui = 0;
    if (!S.next(0, cur)) return;
    f32x4 acc[2][2][4][2];
#pragma unroll
    for (int a = 0; a < 2; ++a)
#pragma unroll
        for (int b = 0; b < 2; ++b)
#pragma unroll
            for (int m = 0; m < 4; ++m)
#pragma unroll
                for (int n = 0; n < 2; ++n) acc[a][b][m][n] = (f32x4){0.f, 0.f, 0.f, 0.f};
    bf16x8 At[4][2], B0[2][2], B1[2][2];
    const char* cA = (const char*)g.A + (size_t)cur.pm * tstep; const char* cB = (const char*)g.Bt + (size_t)cur.pn * tstep;
    S.a_ready(cur);
#define PG8_RS_DMA(pm_, slot_) do { if constexpr (Epi::RS_LDS) { if (wid == 0) { unsigned lo_ = (unsigned)lane * 16u; asm volatile("" : "+v"(lo_));     \
        __builtin_amdgcn_global_load_lds((const unsigned*)((const char*)(E.rs + (size_t)(pm_) * BM) + lo_), (PG8_LAS unsigned*)(lds + STAGE_BYTES + (slot_) * 1024), 16, 0, 0); } } } while (0)
    PG8_RS_DMA(cur.pm, 0);
    if constexpr (SP2) {
        PG8_STAGE(PG8_SB(0, 0), cB, voffB); PG8_STAGE(PG8_SB(0, 1), cB + hstepB, voffB); PG8_STAGE(PG8_SA(0, 0), cA, voffA); PG8_STAGE(PG8_SA(0, 1), cA + hstepA, voffA);
        if (wr == 1) PG8_BAR;
        PG8_WAIT_V(2); PG8_BAR;
        PG8_STAGE(PG8_SB(1, 0), cB + kstepB, voffB); PG8_STAGE(PG8_SA(1, 0), cA + kstepA, voffA); PG8_STAGE(PG8_SB(1, 1), cB + hstepB + kstepB, voffB);
        PG8_WAIT_V(6); PG8_BAR;
    } else {
        PG8_STAGE(PG8_SB(0, 0), cB, voffB); PG8_STAGE(PG8_SA(0, 0), cA, voffA); PG8_STAGE(PG8_SB(0, 1), cB + hstepB, voffB); PG8_STAGE(PG8_SA(0, 1), cA + hstepA, voffA);
        if (wr == 1) PG8_BAR;
        PG8_WAIT_V(4); PG8_BAR;
        PG8_STAGE(PG8_SB(1, 0), cB + kstepB, voffB); PG8_STAGE(PG8_SA(1, 0), cA + kstepA, voffA); PG8_STAGE(PG8_SB(1, 1), cB + hstepB + kstepB, voffB);
        PG8_WAIT_V(6); PG8_BAR;
    }
#define PG8_ITER_SP2(DO_A11, NWAIT) do { \
              \
            PG8_LDB(B0, 0, 0); PG8_LDB(B1, 0, 1); PG8_SCHED; PG8_LDA(At, 0, 0); if (DO_A11) PG8_STAGE(PG8_SA(1, 1), a1 + hstepA, voffA); \
            PG8_WAIT_VN(NWAIT); PG8_WAIT_L(0); PG8_BAR; PG8_MMA(0, 0, At, B0); PG8_MMA(0, 1, At, B1); PG8_BAR; PG8_SCHED; \
              \
            PG8_LDA(At, 0, 1); PG8_STAGE(PG8_SB(0, 0), b2, voffB); PG8_STAGE(PG8_SB(0, 1), b2 + hstepB, voffB); PG8_STAGE(PG8_SA(0, 0), a2, voffA); \
            PG8_WAIT_VN(NWAIT); PG8_WAIT_L(0); PG8_BAR; PG8_MMA(1, 0, At, B0); PG8_MMA(1, 1, At, B1); PG8_BAR; PG8_SCHED; \
              \
            PG8_LDB(B0, 1, 0); PG8_LDB(B1, 1, 1); PG8_SCHED; PG8_LDA(At, 1, 0); PG8_STAGE(PG8_SA(0, 1), a2 + hstepA, voffA); \
            PG8_WAIT_VN(NWAIT); PG8_WAIT_L(0); PG8_BAR; PG8_MMA(0, 0, At, B0); PG8_MMA(0, 1, At, B1); PG8_BAR; PG8_SCHED; \
              \
            PG8_LDA(At, 1, 1); PG8_STAGE(PG8_SB(1, 0), b3, voffB); PG8_STAGE(PG8_SB(1, 1), b3 + hstepB, voffB); PG8_STAGE(PG8_SA(1, 0), a3, voffA); \
            PG8_WAIT_V(8); PG8_WAIT_L(0); PG8_BAR; PG8_MMA(1, 0, At, B0); PG8_MMA(1, 1, At, B1); PG8_BAR; PG8_SCHED; } while (0)
    for (;;) {
        const bool has_next = S.next(ui + 1, nxt);
        const char* nA = has_next ? (const char*)g.A + (size_t)nxt.pm * tstep : cA; const char* nB = has_next ? (const char*)g.Bt + (size_t)nxt.pn * tstep : cB;
        int t0 = 0;
        if constexpr (SP2 && ALIGN_EPI && MK_FRESH && Epi::FRESH_OK) { if (ui > 0) {
            const char* a1 = cA + kstepA; const char* a2 = cA + 2 * kstepA; const char* b2 = cB + 2 * kstepB; const char* a3 = a2 + kstepA; const char* b3 = b2 + kstepB; (void)a1;
            PG8_ITER_SP2(false, 8 + Epi::NST); t0 = 2; } }
        for (int t = t0; t < nt; t += 2) {
            const bool last = (t == nt - 2);
            const char* a1 = cA + (size_t)(t + 1) * kstepA;
            const char* a2 = last ? nA : cA + (size_t)(t + 2) * kstepA; const char* b2 = last ? nB : cB + (size_t)(t + 2) * kstepB;
            const char* a3 = a2 + kstepA; const char* b3 = b2 + kstepB;
            if (last && has_next) S.a_ready(nxt);
            if constexpr (SP2) {
            PG8_ITER_SP2(true, 8);
            } else {
            PG8_LDB(B0, 0, 0); PG8_SCHED; PG8_LDA(At, 0, 0); PG8_STAGE(PG8_SA(1, 1), a1 + hstepA, voffA);
            PG8_WAIT_L(8); PG8_BAR; PG8_WAIT_L(0); PG8_MMA(0, 0, At, B0); PG8_BAR; PG8_SCHED;
            PG8_LDB(B1, 0, 1); PG8_STAGE(PG8_SB(0, 0), b2, voffB);
            PG8_BAR; PG8_WAIT_L(0); PG8_MMA(0, 1, At, B1); PG8_BAR;
            PG8_LDA(At, 0, 1); PG8_STAGE(PG8_SA(0, 0), a2, voffA);
            PG8_BAR; PG8_WAIT_L(0); PG8_MMA(1, 0, At, B0); PG8_BAR; PG8_SCHED;
            PG8_STAGE(PG8_SB(0, 1), b2 + hstepB, voffB);
            PG8_WAIT_V(6); PG8_BAR; PG8_MMA(1, 1, At, B1); PG8_BAR;
            PG8_LDB(B0, 1, 0); PG8_SCHED; PG8_LDA(At, 1, 0); PG8_STAGE(PG8_SA(0, 1), a2 + hstepA, voffA);
            PG8_WAIT_L(8); PG8_BAR; PG8_WAIT_L(0); PG8_MMA(0, 0, At, B0); PG8_BAR; PG8_SCHED;
            PG8_LDB(B1, 1, 1); PG8_STAGE(PG8_SB(1, 0), b3, voffB);
            PG8_BAR; PG8_WAIT_L(0); PG8_MMA(0, 1, At, B1); PG8_BAR;
            PG8_LDA(At, 1, 1); PG8_STAGE(PG8_SA(1, 0), a3, voffA);
            PG8_BAR; PG8_WAIT_L(0); PG8_MMA(1, 0, At, B0); PG8_BAR; PG8_SCHED;
            PG8_STAGE(PG8_SB(1, 1), b3 + hstepB, voffB);
            PG8_WAIT_V(6); PG8_BAR; PG8_MMA(1, 1, At, B1); PG8_BAR;
            }
        }
        if constexpr (ALIGN_EPI) { if (wr == 0) PG8_BAR; }
        if (has_next) PG8_RS_DMA(nxt.pm, (ui + 1) & 1);
        if constexpr (SP2 && ALIGN_EPI && MK_FRESH && Epi::FRESH_OK) { if (has_next) PG8_STAGE(PG8_SA(1, 1), nA + kstepA + hstepA, voffA); asm volatile("" ::: "memory"); PG8_SCHED; }
        if constexpr (!Epi::AFTER_DRAIN) { E(acc, cur, wr, wc, fr, fq, (const PG8_LAS float*)(lds + STAGE_BYTES + (ui & 1) * 1024)); S.done(cur); }
        if (!has_next) break;
#pragma unroll
        for (int a = 0; a < 2; ++a)
#pragma unroll
            for (int b = 0; b < 2; ++b)
#pragma unroll
                for (int m = 0; m < 4; ++m)
#pragma unroll
                    for (int n = 0; n < 2; ++n) acc[a][b][m][n] = (f32x4){0.f, 0.f, 0.f, 0.f};
        cur = nxt; cA = nA; cB = nB; ++ui;
        if constexpr (ALIGN_EPI) { if (wr == 1) PG8_BAR; }
    }
    PG8_WAIT_V(0);
    if constexpr (!ALIGN_EPI) { if (wr == 0) PG8_BAR; }
    PG8_BAR;
    if constexpr (Epi::AFTER_DRAIN) { E.fused(acc, cur, wr, wc, fr, fq, lds, wid, lane); S.done(cur); }
#undef PG8_SA
#undef PG8_SB
#undef PG8_STAGE
#undef PG8_LDA
#undef PG8_LDB
#undef PG8_MMA
#undef PG8_RS_DMA
#undef PG8_ITER_SP2
#undef PG8_WAIT_V
#undef PG8_WAIT_VN
#undef PG8_WAIT_L
#undef PG8_BAR
#undef PG8_SCHED
}
}
namespace att {
constexpr int D = 128; constexpr float THR = 8.f; constexpr bool WSKIP = false;
constexpr float SCALE = 0.08838834764831845f;
constexpr int NW = 8, QBLK = 32, KVBLK = 64, QB = NW * QBLK;
constexpr int SHM_V = KVBLK * D * 2, SHM_K = KVBLK * D * 2;
constexpr int LDS_BYTES = 2 * SHM_V + 2 * SHM_K + NW * 64 * 4;

typedef short bf16x8 __attribute__((ext_vector_type(8)));
typedef short s16x4 __attribute__((ext_vector_type(4)));
typedef float f32x16 __attribute__((ext_vector_type(16)));
typedef float f32x4 __attribute__((ext_vector_type(4)));
typedef unsigned u32x4 __attribute__((ext_vector_type(4)));
template <class A, class Bt> struct same_t { static constexpr bool v = false; };
template <class A> struct same_t<A, A> { static constexpr bool v = true; };

#define KSWZ(row, colB) ((row) * 256 + ((colB) ^ (((row) & 7) << 4)))
#define SBAR() __builtin_amdgcn_sched_barrier(0)
__device__ __forceinline__ int v_st(int k, int c) { const int kk = (k & ~0xC) | ((k & 4) << 1) | ((k & 8) >> 1); return ((kk >> 3) * 4 + (c >> 5)) * 512 + ((kk & 7) * 32 + (c & 31)) * 2; }
__device__ __forceinline__ int v_rd_base(int lane) { return ((lane & 3) << 3) | (((lane >> 2) & 3) << 6) | (((lane >> 4) & 1) << 5) | (((lane >> 5) & 1) << 8); }
constexpr int v_rd_off(int d0, int ks, int half) { return d0 * 512 + ks * 4096 + half * 2048; }
__device__ __forceinline__ int crow(int r, int hi) { return (r & 3) + 8 * (r >> 2) + 4 * hi; }
__device__ __forceinline__ unsigned cvtpk(float lo, float hi) {
    unsigned r; asm volatile("v_cvt_pk_bf16_f32 %0, %1, %2" : "=v"(r) : "v"(lo), "v"(hi)); return r;
}
__device__ __forceinline__ bf16x8 pack8(f32x4 a, f32x4 b) {
    u32x4 w = {cvtpk(a[0], a[1]), cvtpk(a[2], a[3]), cvtpk(b[0], b[1]), cvtpk(b[2], b[3])};
    return *reinterpret_cast<bf16x8*>(&w);
}
template <class T> __device__ __forceinline__ bf16x8 load8(const T* p) {
    if constexpr (same_t<T, float>::v) { return pack8(*(const f32x4*)p, *(const f32x4*)(p + 4)); }
    else { return *reinterpret_cast<const bf16x8*>(p); }
}
__device__ __forceinline__ void mask_tile(f32x16& p0, f32x16& p1, int dq, unsigned W) {
    const float NEG = -__builtin_inff();
#pragma unroll
    for (int r = 0; r < 16; ++r) {
        const int c = (r & 3) + 8 * (r >> 2);
        if ((unsigned)(dq - c) >= W) p0[r] = NEG;
        if ((unsigned)(dq - c - 32) >= W) p1[r] = NEG;
    }
}
__device__ __forceinline__ void partialSM(f32x16& p0, f32x16& p1, float& m_reg, float& mn, float& alpha) {
    float pmax = p0[0]; for (int r = 1; r < 16; ++r) pmax = fmaxf(pmax, p0[r]); for (int r = 0; r < 16; ++r) pmax = fmaxf(pmax, p1[r]);
    { auto rr = __builtin_amdgcn_permlane32_swap(__float_as_uint(pmax), __float_as_uint(pmax), false, false);
      pmax = fmaxf(__uint_as_float(rr[0]), __uint_as_float(rr[1])); }
    constexpr float C2 = 1.4426950408889634f * SCALE;
    if (__builtin_expect(__all((pmax - m_reg) * SCALE <= THR), 1)) { mn = m_reg; alpha = 1.f; }
    else { mn = fmaxf(m_reg, pmax); alpha = __builtin_amdgcn_exp2f((m_reg - mn) * C2); m_reg = mn; }
    const float mnL = -mn * C2;
    for (int r = 0; r < 16; ++r) p0[r] = fmaf(p0[r], C2, mnL); for (int r = 0; r < 16; ++r) p1[r] = fmaf(p1[r], C2, mnL);
    for (int r = 0; r < 16; ++r) p0[r] = __builtin_amdgcn_exp2f(p0[r]);
}
__device__ __forceinline__ void finishSM(f32x16& p0, f32x16& p1, float alpha, float& l_reg, bf16x8& pa0, bf16x8& pa1, bf16x8& pa2, bf16x8& pa3) {
    for (int r = 0; r < 16; ++r) p1[r] = __builtin_amdgcn_exp2f(p1[r]);
    float ps = 0; for (int r = 0; r < 16; ++r) ps += p0[r]; for (int r = 0; r < 16; ++r) ps += p1[r];
    { auto rr = __builtin_amdgcn_permlane32_swap(__float_as_uint(ps), __float_as_uint(ps), false, false);
      ps = __uint_as_float(rr[0]) + __uint_as_float(rr[1]); }
    l_reg = l_reg * alpha + ps;
#define PK4(P, B_, OUT) do { unsigned a0 = cvtpk(P[B_+0], P[B_+1]), a1 = cvtpk(P[B_+2], P[B_+3]);                          \
        unsigned b0 = cvtpk(P[B_+4], P[B_+5]), b1 = cvtpk(P[B_+6], P[B_+7]);                                             \
        auto r0 = __builtin_amdgcn_permlane32_swap(a0, b0, false, false); auto r1 = __builtin_amdgcn_permlane32_swap(a1, b1, false, false); \
        u32x4 w = {r0[0], r1[0], r0[1], r1[1]}; OUT = *reinterpret_cast<bf16x8*>(&w); } while (0)
    PK4(p0, 0, pa0); PK4(p0, 8, pa1); PK4(p1, 0, pa2); PK4(p1, 8, pa3);
#undef PK4
}
template <int KB, bool SK>
__device__ __forceinline__ void qkt(f32x16& p0, f32x16& p1, const char* K_lds, int r32, int hi, const bf16x8* qr, bool act) {
    if (SK && !act) { const float NEG = -__builtin_inff();
#pragma unroll
        for (int r = 0; r < 16; ++r) { p0[r] = NEG; p1[r] = NEG; } return; }
    p0 = f32x16{}; p1 = f32x16{};
    const char* kb[4];
#pragma unroll
    for (int dd = 0; dd < 4; ++dd) kb[dd] = K_lds + KB * SHM_K + KSWZ(r32, (dd * 16 + hi * 8) * 2);
#pragma unroll
    for (int d0 = 0; d0 < 8; ++d0) { const char* a = kb[d0 & 3] + (d0 >> 2) * 128;
        bf16x8 b0 = *reinterpret_cast<const bf16x8*>(a);
        bf16x8 b1 = *reinterpret_cast<const bf16x8*>(a + 32 * 256);
        p0 = __builtin_amdgcn_mfma_f32_32x32x16_bf16(b0, qr[d0], p0, 0, 0, 0);
        p1 = __builtin_amdgcn_mfma_f32_32x32x16_bf16(b1, qr[d0], p1, 0, 0, 0); }
}
template <int VB, bool SK>
__device__ __forceinline__ void pv_tile(f32x16* o, int vb0, bf16x8 pa0, bf16x8 pa1, bf16x8 pa2, bf16x8 pa3, bool act) {
    if (SK && !act) return;
#define TRRD(dst, off) asm volatile("ds_read_b64_tr_b16 %0, %1 offset:%2" : "=&v"(dst) : "v"(vb0), "i"(off) : "memory")
#define PV_D0(d0) do { s16x4 l0, l1, l2, l3, h0, h1, h2, h3; constexpr int b_ = VB * SHM_V + v_rd_off(d0, 0, 0);     \
        TRRD(l0, b_); TRRD(h0, b_ + 2048); TRRD(l1, b_ + 4096); TRRD(h1, b_ + 6144); TRRD(l2, b_ + 8192); TRRD(h2, b_ + 10240); TRRD(l3, b_ + 12288); TRRD(h3, b_ + 14336); \
        asm volatile("s_waitcnt lgkmcnt(0)" ::: "memory"); SBAR();                 \
        o[d0] = __builtin_amdgcn_mfma_f32_32x32x16_bf16(pa0, (bf16x8){l0[0], l0[1], l0[2], l0[3], h0[0], h0[1], h0[2], h0[3]}, o[d0], 0, 0, 0);   \
        o[d0] = __builtin_amdgcn_mfma_f32_32x32x16_bf16(pa1, (bf16x8){l1[0], l1[1], l1[2], l1[3], h1[0], h1[1], h1[2], h1[3]}, o[d0], 0, 0, 0);   \
        o[d0] = __builtin_amdgcn_mfma_f32_32x32x16_bf16(pa2, (bf16x8){l2[0], l2[1], l2[2], l2[3], h2[0], h2[1], h2[2], h2[3]}, o[d0], 0, 0, 0);   \
        o[d0] = __builtin_amdgcn_mfma_f32_32x32x16_bf16(pa3, (bf16x8){l3[0], l3[1], l3[2], l3[3], h3[0], h3[1], h3[2], h3[3]}, o[d0], 0, 0, 0); } while (0)
    PV_D0(0); PV_D0(1); PV_D0(2); PV_D0(3);
#undef PV_D0
#undef TRRD
}

template <class TIn, class TOut> struct BlockRef { const TIn* Q; const TIn* K; const TIn* V; TOut* O; int P0; };
template <class TIn> struct Seam {
    bf16x8 qr[8];
    bf16x8 st_v0, st_v1, st_k0, st_k1; f32x4 sf0, sf1, sf2, sf3;
    f32x4 tq[16];
};
__device__ __forceinline__ int swa_jlo(int P0, int W) { const int lowk = P0 - W + 1; return lowk > 0 ? lowk / KVBLK : 0; }
#define ROW(p, k0, rr) ((p) + (size_t)((k0) + (rr)) * D + sc)
#define VMW() asm volatile("s_waitcnt vmcnt(0)" ::: "memory")
#define VMWN(n) asm volatile("s_waitcnt vmcnt(%0)" :: "i"(n) : "memory")
#define SLOAD_H(Kp, Vp, k0) do { S.st_v0 = load8<TIn>(ROW(Vp, k0, sr)); S.st_v1 = load8<TIn>(ROW(Vp, k0, 32 + sr));              \
                         S.st_k0 = load8<TIn>(ROW(Kp, k0, sr)); S.st_k1 = load8<TIn>(ROW(Kp, k0, 32 + sr)); } while (0)
#define SWRITE_HK(bf) do { *(bf16x8*)(K_lds + (bf) * SHM_K + kws) = S.st_k0; *(bf16x8*)(K_lds + (bf) * SHM_K + kws + 32 * 256) = S.st_k1; } while (0)
#define SWRITE_HV(bf) do { *(bf16x8*)(V_lds + (bf) * SHM_V + vst0) = S.st_v0; *(bf16x8*)(V_lds + (bf) * SHM_V + vst1) = S.st_v1; } while (0)
#define SWRITE_H(bf) do { SWRITE_HV(bf); SWRITE_HK(bf); } while (0)
#define SLOAD_F(p, k0) do { S.sf0 = *(const f32x4*)ROW(p, k0, sr); S.sf1 = *(const f32x4*)(ROW(p, k0, sr) + 4);                \
                            S.sf2 = *(const f32x4*)ROW(p, k0, 32 + sr); S.sf3 = *(const f32x4*)(ROW(p, k0, 32 + sr) + 4); } while (0)
#define SWRITE_KF(bf) do { *(bf16x8*)(K_lds + (bf) * SHM_K + kws) = pack8(S.sf0, S.sf1); *(bf16x8*)(K_lds + (bf) * SHM_K + kws + 32 * 256) = pack8(S.sf2, S.sf3); } while (0)
#define SWRITE_VF(bf) do { *(bf16x8*)(V_lds + (bf) * SHM_V + vst0) = pack8(S.sf0, S.sf1); *(bf16x8*)(V_lds + (bf) * SHM_V + vst1) = pack8(S.sf2, S.sf3); } while (0)
template <class TIn, class TOut>
__device__ __forceinline__ void causal_swa_prime(const BlockRef<TIn, TOut>& cur, int W, char* lds, Seam<TIn>& S) {
    constexpr bool F32 = same_t<TIn, float>::v;
    const int tid = threadIdx.x, wid = __builtin_amdgcn_readfirstlane(tid >> 6), lane = tid & 63, r32 = lane & 31, hi = lane >> 5;
    const int sr = tid >> 4, sc = (tid & 15) * 8, kws = KSWZ(sr, sc * 2); char* K_lds = lds + 2 * SHM_V;
    const int kb0 = swa_jlo(cur.P0, W) * KVBLK;
    for (int d0 = 0; d0 < 8; ++d0) S.qr[d0] = load8<TIn>(cur.Q + (size_t)(wid * QBLK + r32) * D + d0 * 16 + hi * 8);
    if constexpr (F32) { SLOAD_F((const float*)cur.K, kb0); VMW(); SWRITE_KF(0); SBAR(); SLOAD_F((const float*)cur.V, kb0); }
    else { SLOAD_H(cur.K, cur.V, kb0); VMW(); SWRITE_HK(0); }
    __syncthreads();
}
template <class TIn, class TOut>
__device__ __forceinline__ void causal_swa_block(const BlockRef<TIn, TOut>& cur, const BlockRef<TIn, TOut>& nxt, int skv, int W, char* lds, Seam<TIn>& S) {
    constexpr bool F32 = same_t<TIn, float>::v;
    const int tid = threadIdx.x, wid = __builtin_amdgcn_readfirstlane(tid >> 6), lane = tid & 63, r32 = lane & 31, hi = lane >> 5;
    const int j_lo = swa_jlo(cur.P0, W);
    int j_hi = (cur.P0 + QB - 1) / KVBLK + 1; if (j_hi > skv / KVBLK) j_hi = skv / KVBLK;
    const int NT = j_hi - j_lo;
    const int kbn = swa_jlo(nxt.P0, W) * KVBLK;
    const int qlo = cur.P0 + wid * QBLK, qm = qlo + r32 - 4 * hi;
    char* V_lds = lds; char* K_lds = lds + 2 * SHM_V;
    float* ws = (float*)(lds + 2 * SHM_V + 2 * SHM_K) + wid * 64; float* li_l = ws, * al_l = ws + 32;
    float m_reg = -1e30f, l_reg = 0; f32x16 o[4] = {};
    const int sr = tid >> 4, sc = (tid & 15) * 8, vst0 = v_st(sr, sc), vst1 = v_st(32 + sr, sc), kws = KSWZ(sr, sc * 2);
    const int vb0 = (int)(uintptr_t)V_lds + v_rd_base(lane);
    const TIn* Kh = cur.K; const TIn* Vh = cur.V;
#define RESC(a) do { if (__any((a) < 1.f)) { if (hi == 0) al_l[r32] = (a); asm volatile("s_waitcnt lgkmcnt(0)" ::: "memory");              \
                     for (int d_ = 0; d_ < 4; ++d_) for (int r = 0; r < 16; ++r) o[d_][r] *= al_l[crow(r, hi)]; } } while (0)
#define KBASE(t) ((j_lo + (t)) * KVBLK)
#define ACT(t) (KBASE(t) <= qlo + QBLK - 1 && KBASE(t) + KVBLK - 1 >= qlo - W + 1)
#define MASKT(P0_, P1_, t) do { const int kb_ = KBASE(t); if ((!SK || ACT(t)) && (kb_ + KVBLK - 1 > qlo || kb_ <= qlo + QBLK - 1 - W)) mask_tile(P0_, P1_, qm - kb_, (unsigned)W); } while (0)
    constexpr int NQL = F32 ? 16 : 8;
    constexpr bool SK = WSKIP && !F32;
#define SEAM_K0() do { VMWN(NQL); if constexpr (F32) { SWRITE_KF(0); SBAR(); SLOAD_F((const float*)nxt.V, kbn); } else { SWRITE_HK(0); } SBAR(); } while (0)
    f32x16 pA0, pA1, pB0, pB1; float mnA, mnB, alA, alB; bf16x8 pa0, pa1, pa2, pa3;
    if constexpr (F32) { VMW(); SWRITE_VF(0); SBAR(); } else { SWRITE_HV(0); SBAR(); }
    if (NT > 1) { if constexpr (F32) SLOAD_F((const float*)Kh, KBASE(1)); else SLOAD_H(Kh, Vh, KBASE(1)); }
    SBAR(); qkt<0, SK>(pA0, pA1, K_lds, r32, hi, S.qr, ACT(0));
    if constexpr (F32) { if (NT > 1) { VMW(); SWRITE_KF(1); SBAR(); SLOAD_F((const float*)Vh, KBASE(1)); } }
    MASKT(pA0, pA1, 0); partialSM(pA0, pA1, m_reg, mnA, alA);
    if (NT > 1) { VMW(); if constexpr (F32) { SWRITE_VF(1); SBAR(); if (NT > 2) SLOAD_F((const float*)Kh, KBASE(2)); } else SWRITE_H(1); }
    __syncthreads();
#define HALF_STEP(PX0, PX1, mnX, alX, PY0, PY1, alY, t, KB, VB, SB) do {                                                      \
        SBAR(); qkt<KB, SK>(PX0, PX1, K_lds, r32, hi, S.qr, ACT(t));                                             \
        finishSM(PY0, PY1, alY, l_reg, pa0, pa1, pa2, pa3); SBAR();                                                           \
        if ((t) + 1 < NT) { if constexpr (F32) { VMW(); SWRITE_KF(SB); SBAR(); SLOAD_F((const float*)Vh, KBASE((t) + 1)); }  \
                            else { SLOAD_H(Kh, Vh, KBASE((t) + 1)); } SBAR(); }                                               \
        pv_tile<VB, SK>(o, vb0, pa0, pa1, pa2, pa3, ACT((t) - 1)); MASKT(PX0, PX1, (t)); partialSM(PX0, PX1, m_reg, mnX, alX);                                        \
        __syncthreads();                                                                                                      \
        if ((t) + 1 < NT) { VMW(); if constexpr (F32) { SWRITE_VF(SB); SBAR(); if ((t) + 2 < NT) SLOAD_F((const float*)Kh, KBASE((t) + 2)); } \
                            else { SWRITE_H(SB); } }                                                                          \
        RESC(alX); __syncthreads(); } while (0)
    for (int t = 1; t + 1 < NT; t += 2) {
        HALF_STEP(pB0, pB1, mnB, alB, pA0, pA1, alA, t, 1, 0, 0);
        HALF_STEP(pA0, pA1, mnA, alA, pB0, pB1, alB, t + 1, 0, 1, 1);
    }
    const bool even = (NT & 1) == 0;
    if (even) { SBAR(); qkt<1, SK>(pB0, pB1, K_lds, r32, hi, S.qr, ACT(NT - 1)); SBAR(); }
#define QROW(e) (nxt.Q + (size_t)(wid * QBLK + r32) * D + ((e) >> 1) * 16 + hi * 8 + ((e) & 1) * 4)
    if constexpr (F32) { SLOAD_F((const float*)nxt.K, kbn); SBAR();
#pragma unroll
        for (int e = 0; e < 8; ++e) S.tq[e] = *(const f32x4*)QROW(e); }
    else { SLOAD_H(nxt.K, nxt.V, kbn); SBAR();
#pragma unroll
        for (int d0 = 0; d0 < 8; ++d0) S.qr[d0] = load8<TIn>(nxt.Q + (size_t)(wid * QBLK + r32) * D + d0 * 16 + hi * 8); }
    SBAR();
    finishSM(pA0, pA1, alA, l_reg, pa0, pa1, pa2, pa3); SBAR();
    if constexpr (F32) {
#pragma unroll
        for (int e = 8; e < 16; ++e) S.tq[e] = *(const f32x4*)QROW(e); SBAR(); }
#undef QROW
    pv_tile<0, SK>(o, vb0, pa0, pa1, pa2, pa3, ACT(even ? NT - 2 : NT - 1));
    if (even) { MASKT(pB0, pB1, NT - 1); partialSM(pB0, pB1, m_reg, mnB, alB); __syncthreads(); RESC(alB);
        finishSM(pB0, pB1, alB, l_reg, pa0, pa1, pa2, pa3); SBAR(); pv_tile<1, SK>(o, vb0, pa0, pa1, pa2, pa3, ACT(NT - 1)); }
    SBAR(); SEAM_K0();
    if (hi == 0) li_l[r32] = l_reg; asm volatile("s_waitcnt lgkmcnt(0)" ::: "memory");
    float rli[16];
#pragma unroll
    for (int r = 0; r < 16; ++r) rli[r] = __builtin_amdgcn_rcpf(li_l[crow(r, hi)]);
    TOut* Ow = cur.O + (size_t)(wid * QBLK) * D;
#pragma unroll
    for (int r = 0; r < 16; ++r) { const int orow = crow(r, hi);
#pragma unroll
        for (int d0 = 0; d0 < 4; ++d0) { const float v = o[d0][r] * rli[r];
            if constexpr (same_t<TOut, float>::v) { Ow[(size_t)orow * D + d0 * 32 + r32] = v; }
            else { const float vn = __shfl_xor(v, 1);
                   if ((r32 & 1) == 0) *(unsigned*)(Ow + (size_t)orow * D + d0 * 32 + r32) = cvtpk(v, vn); } } }
    if constexpr (F32) {
#pragma unroll
        for (int d0 = 0; d0 < 8; ++d0) S.qr[d0] = pack8(S.tq[2 * d0], S.tq[2 * d0 + 1]); }
    __syncthreads();
#undef RESC
#undef KBASE
#undef ACT
#undef MASKT
#undef SEAM_K0
#undef HALF_STEP
}
#undef ROW
#undef VMW
#undef VMWN
#undef SLOAD_H
#undef SWRITE_HK
#undef SWRITE_HV
#undef SWRITE_H
#undef SLOAD_F
#undef SWRITE_KF
#undef SWRITE_VF

template <int VB0>
__device__ __forceinline__ void pv8(f32x16* o, int vb0, bf16x8 pa0, bf16x8 pa1, bf16x8 pa2, bf16x8 pa3) {
    s16x4 l0, h0, l1, h1, l2, h2, l3, h3;
#define TRRD(dst, off) asm volatile("ds_read_b64_tr_b16 %0, %1 offset:%2" : "=&v"(dst) : "v"(vb0), "i"(off) : "memory")
#define PV8_OFF(d0) ((VB0 + ((d0) >> 2)) * SHM_V + v_rd_off((d0) & 3, 0, 0))
#define PV8_RX(d0) do { TRRD(l0, PV8_OFF(d0)); TRRD(h0, PV8_OFF(d0) + 2048); TRRD(l1, PV8_OFF(d0) + 4096); TRRD(h1, PV8_OFF(d0) + 6144); } while (0)
#define PV8_RY(d0) do { TRRD(l2, PV8_OFF(d0) + 8192); TRRD(h2, PV8_OFF(d0) + 10240); TRRD(l3, PV8_OFF(d0) + 12288); TRRD(h3, PV8_OFF(d0) + 14336); } while (0)
#define PV8_STEP(d0, LAST) do { \
        asm volatile("s_waitcnt lgkmcnt(4)" ::: "memory"); SBAR(); \
        o[d0] = __builtin_amdgcn_mfma_f32_32x32x16_bf16(pa0, (bf16x8){l0[0], l0[1], l0[2], l0[3], h0[0], h0[1], h0[2], h0[3]}, o[d0], 0, 0, 0); \
        o[d0] = __builtin_amdgcn_mfma_f32_32x32x16_bf16(pa1, (bf16x8){l1[0], l1[1], l1[2], l1[3], h1[0], h1[1], h1[2], h1[3]}, o[d0], 0, 0, 0); SBAR(); \
        if (!(LAST)) { PV8_RX((d0) + 1); asm volatile("s_waitcnt lgkmcnt(4)" ::: "memory"); } else { asm volatile("s_waitcnt lgkmcnt(0)" ::: "memory"); } SBAR(); \
        o[d0] = __builtin_amdgcn_mfma_f32_32x32x16_bf16(pa2, (bf16x8){l2[0], l2[1], l2[2], l2[3], h2[0], h2[1], h2[2], h2[3]}, o[d0], 0, 0, 0); \
        o[d0] = __builtin_amdgcn_mfma_f32_32x32x16_bf16(pa3, (bf16x8){l3[0], l3[1], l3[2], l3[3], h3[0], h3[1], h3[2], h3[3]}, o[d0], 0, 0, 0); SBAR(); \
        if (!(LAST)) PV8_RY((d0) + 1); } while (0)
    PV8_RX(0); PV8_RY(0);
    PV8_STEP(0, false); PV8_STEP(1, false); PV8_STEP(2, false); PV8_STEP(3, false); PV8_STEP(4, false); PV8_STEP(5, false); PV8_STEP(6, false); PV8_STEP(7, true);
#undef PV8_STEP
#undef PV8_RY
#undef PV8_RX
#undef PV8_OFF
#undef TRRD
}
struct Ref2 { const unsigned short* Q; const unsigned short* K; const unsigned short* V0; const unsigned short* V1; float* X; unsigned short* RA; float lam; int P0; };
constexpr int A2_LDS = 4 * SHM_V + 2 * SHM_K + NW * 64 * 4;
template <int MODE  >
__device__ __forceinline__ void attn2_block(const Ref2& cur, char* lds, int wave_id) {
    typedef unsigned short T;
    constexpr int W = 1 << 20;
    const int lane = mk_lane(), wid = wave_id, r32 = lane & 31, hi = lane >> 5;
    const int NT = (cur.P0 + QB) / KVBLK;
    const int qlo = cur.P0 + wid * QBLK, qm = qlo + r32 - 4 * hi;
    char* V_lds = lds; char* K_lds = lds + 4 * SHM_V;
    float* ws = (float*)(lds + 4 * SHM_V + 2 * SHM_K) + wid * 64; float* li_l = ws; float* al_l = ws + 32;
    const int vb0 = (int)(uintptr_t)V_lds + v_rd_base(lane);
    bf16x8 qr[8];
#pragma unroll
    for (int d0 = 0; d0 < 8; ++d0) qr[d0] = load8<T>(cur.Q + (size_t)(wid * QBLK + r32) * D + d0 * 16 + hi * 8);
    const unsigned krow = 4 * wid + (lane >> 4), kgo = krow * 256 + (((lane & 15) * 16) ^ ((krow & 7) << 4));
    const unsigned vkk = 8 * (wid >> 1) + ((lane & 31) >> 2), vk = (vkk & ~0xCu) | ((vkk & 4) << 1) | ((vkk & 8) >> 1), vgo = vk * 256 + (32 * (2 * (wid & 1) + (lane >> 5)) + 8 * (lane & 3)) * 2;
    typedef __attribute__((address_space(3))) unsigned lds_u32;
#define A2_DMA(k0, bf) do { const char* kp_ = (const char*)cur.K + (size_t)(k0) * 256; const char* v0_ = (const char*)cur.V0 + (size_t)(k0) * 256; const char* v1_ = (const char*)cur.V1 + (size_t)(k0) * 256; \
        char* kl_ = K_lds + (bf) * SHM_K + wid * 1024; char* vl_ = V_lds + (2 * (bf)) * SHM_V + wid * 1024; \
        __builtin_amdgcn_global_load_lds((const unsigned*)(kp_ + kgo), (lds_u32*)kl_, 16, 0, 0); __builtin_amdgcn_global_load_lds((const unsigned*)(kp_ + 8192 + kgo), (lds_u32*)(kl_ + 8192), 16, 0, 0); \
        __builtin_amdgcn_global_load_lds((const unsigned*)(v0_ + vgo), (lds_u32*)vl_, 16, 0, 0); __builtin_amdgcn_global_load_lds((const unsigned*)(v0_ + 8192 + vgo), (lds_u32*)(vl_ + 8192), 16, 0, 0); \
        __builtin_amdgcn_global_load_lds((const unsigned*)(v1_ + vgo), (lds_u32*)(vl_ + SHM_V), 16, 0, 0); __builtin_amdgcn_global_load_lds((const unsigned*)(v1_ + 8192 + vgo), (lds_u32*)(vl_ + SHM_V + 8192), 16, 0, 0); } while (0)
    A2_DMA(0, 0);
    asm volatile("s_waitcnt vmcnt(0)" ::: "memory"); __syncthreads();
    float m_reg = -1e30f, l_reg = 0.f; f32x16 o[8] = {};
#define A2_STEP(t, BF) do { \
        f32x16 p0, p1; SBAR(); qkt<BF, false>(p0, p1, K_lds, r32, hi, qr, true); SBAR(); \
        if ((t) + 1 < NT) A2_DMA(((t) + 1) * KVBLK, 1 - BF);     \
        SBAR(); \
        { const int kb_ = (t) * KVBLK; if (kb_ + KVBLK - 1 > qlo) mask_tile(p0, p1, qm - kb_, (unsigned)W); } \
        float mn, al; partialSM(p0, p1, m_reg, mn, al); bf16x8 pa0, pa1, pa2, pa3; finishSM(p0, p1, al, l_reg, pa0, pa1, pa2, pa3); SBAR(); \
        if (__any(al < 1.f)) { if (hi == 0) al_l[r32] = al; asm volatile("s_waitcnt lgkmcnt(0)" ::: "memory"); \
            _Pragma("unroll") for (int r = 0; r < 16; ++r) { const float a_ = al_l[crow(r, hi)]; _Pragma("unroll") for (int d_ = 0; d_ < 8; ++d_) o[d_][r] *= a_; } } \
        pv8<2 * BF>(o, vb0, pa0, pa1, pa2, pa3); \
        asm volatile("s_waitcnt vmcnt(0)" ::: "memory"); __syncthreads(); } while (0)
    for (int t = 0; t < NT; t += 2) { A2_STEP(t, 0); A2_STEP(t + 1, 1); }
#undef A2_STEP
#undef A2_DMA
    int r32e = r32, hie = hi, le = lane; asm volatile("" : "+v"(r32e), "+v"(hie), "+v"(le));
    if (hie == 0) li_l[r32e] = l_reg; asm volatile("s_waitcnt lgkmcnt(0)" ::: "memory");
#pragma unroll
    for (int r = 0; r < 16; ++r) { const float rl = __builtin_amdgcn_rcpf(li_l[crow(r, hie)]);
#pragma unroll
        for (int d0 = 0; d0 < 8; ++d0) o[d0][r] *= rl; }
    u32x4* Xw = (u32x4*)cur.X + (size_t)wid * (16 * 64) + le;
    if (MODE == 0) {
#pragma unroll
        for (int d0 = 0; d0 < 8; ++d0)
#pragma unroll
            for (int r8 = 0; r8 < 2; ++r8) { u32x4 w; w.x = cvtpk(o[d0][8 * r8], o[d0][8 * r8 + 1]); w.y = cvtpk(o[d0][8 * r8 + 2], o[d0][8 * r8 + 3]); w.z = cvtpk(o[d0][8 * r8 + 4], o[d0][8 * r8 + 5]); w.w = cvtpk(o[d0][8 * r8 + 6], o[d0][8 * r8 + 7]);
                Xw[(2 * d0 + r8) * 64] = w; }
    } else {
        const float lam = cur.lam;
#pragma unroll
        for (int d0 = 0; d0 < 8; ++d0)
#pragma unroll
            for (int r8 = 0; r8 < 2; ++r8) { const u32x4 a = Xw[(2 * d0 + r8) * 64];
#pragma unroll
                for (int e = 0; e < 4; ++e) { const unsigned w = a[e]; const int r0 = 8 * r8 + 2 * e;
                    o[d0][r0] = __builtin_bit_cast(float, w << 16) - lam * o[d0][r0]; o[d0][r0 + 1] = __builtin_bit_cast(float, w & 0xffff0000u) - lam * o[d0][r0 + 1]; } }
#pragma unroll
        for (int r = 0; r < 16; ++r) { float ss = 0.f;
#pragma unroll
            for (int d0 = 0; d0 < 8; ++d0) ss += o[d0][r] * o[d0][r];
            ss += __shfl_xor(ss, 1); ss += __shfl_xor(ss, 2); ss += __shfl_xor(ss, 4); ss += __shfl_xor(ss, 8); ss += __shfl_xor(ss, 16);
            const float rs_ = __builtin_amdgcn_rsqf(ss * (1.0f / 256.0f) + 1e-5f);
#pragma unroll
            for (int d0 = 0; d0 < 8; ++d0) o[d0][r] *= rs_; }
        char* stg = lds + wid * (32 * 136 * 2);
#pragma unroll
        for (int hf = 0; hf < 2; ++hf) {
#pragma unroll
            for (int r = 0; r < 16; ++r)
#pragma unroll
                for (int d4 = 0; d4 < 4; ++d4) { const float v = o[4 * hf + d4][r]; unsigned short b_; { unsigned u_ = __builtin_bit_cast(unsigned, v); b_ = (unsigned short)((u_ + 0x7fffu + ((u_ >> 16) & 1u)) >> 16); }
                    *(unsigned short*)(stg + (crow(r, hie) * 136 + d4 * 32 + r32e) * 2) = b_; }
            asm volatile("" ::: "memory");
#pragma unroll
            for (int j = 0; j < 8; ++j) { const int row = 4 * j + (le >> 4), ch = le & 15; const u32x4 w = *(const u32x4*)(stg + (row * 136 + ch * 8) * 2);
                *(u32x4*)(cur.RA + (size_t)(wid * QBLK + row) * 4096 + hf * 128 + ch * 8) = w; }
            asm volatile("" ::: "memory");
        }
        __syncthreads();
    }
}
constexpr int A16_V = 32768, A16_K = 16384, A16_KOFF = 2 * A16_V, A16_STAT = A16_KOFF + 2 * A16_K;
typedef __attribute__((address_space(3))) unsigned char a16_lds;
__device__ __forceinline__ bf16x8 a16_cat(s16x4 a, s16x4 b) { return (bf16x8){a[0], a[1], a[2], a[3], b[0], b[1], b[2], b[3]}; }
template <int MODE>
__device__ __forceinline__ void attn16_block(const Ref2& cur, char* lds_g, int wave_id) {
    typedef unsigned short T; typedef __attribute__((address_space(3))) unsigned lds_u32;
    const int lane = mk_lane(), wid = wave_id, fr = lane & 15, fq = lane >> 4, qq = (lane & 15) >> 2, pp = lane & 3;
    const int NT = (cur.P0 + QB) / KVBLK, qlo = cur.P0 + wid * QBLK;
    a16_lds* L = (a16_lds*)lds_g;
    __attribute__((address_space(3))) float* li_l = (__attribute__((address_space(3))) float*)(L + A16_STAT + wid * 256); __attribute__((address_space(3))) float* al_l = li_l + 32;
    bf16x8 qf[2][4];
#pragma unroll
    for (int qb = 0; qb < 2; ++qb)
#pragma unroll
        for (int ks = 0; ks < 4; ++ks) qf[qb][ks] = load8<T>(cur.Q + (size_t)(wid * QBLK + 16 * qb + fr) * D + 32 * ks + 8 * fq);
    const T* Vsrc = ((wid & 3) >> 1) ? cur.V1 : cur.V0;
#define A16_DMA(k0, bf) do { const int ld_ = mk_lane(); int kR, kC; pg8::stage_rc(wid * 1024 + ld_ * 16, kR, kC); const unsigned kgo = (unsigned)(kR * 128 + kC) * 2u; \
        const unsigned vgo = (unsigned)(8 * (wid >> 2) + ((ld_ >> 1) & 7)) * 256u + (unsigned)(16 * ((4 * (wid & 3) + (ld_ >> 4)) & 7) + 8 * (ld_ & 1)) * 2u; const char* kp_ = (const char*)cur.K + (size_t)(k0) * 256; const char* vp_ = (const char*)Vsrc + (size_t)(k0) * 256; \
        char* kl_ = lds_g + A16_KOFF + (bf) * A16_K + wid * 1024; char* vl_ = lds_g + (bf) * A16_V + wid * 1024; \
        __builtin_amdgcn_global_load_lds((const unsigned*)(kp_ + kgo), (lds_u32*)kl_, 16, 0, 0); __builtin_amdgcn_global_load_lds((const unsigned*)(kp_ + 128 + kgo), (lds_u32*)(kl_ + 8192), 16, 0, 0); \
        __builtin_amdgcn_global_load_lds((const unsigned*)(vp_ + vgo), (lds_u32*)vl_, 16, 0, 0); __builtin_amdgcn_global_load_lds((const unsigned*)(vp_ + 4096 + vgo), (lds_u32*)(vl_ + 8192), 16, 0, 0); \
        __builtin_amdgcn_global_load_lds((const unsigned*)(vp_ + 8192 + vgo), (lds_u32*)(vl_ + 16384), 16, 0, 0); __builtin_amdgcn_global_load_lds((const unsigned*)(vp_ + 12288 + vgo), (lds_u32*)(vl_ + 24576), 16, 0, 0); } while (0)
    A16_DMA(0, 0);
    asm volatile("s_waitcnt vmcnt(0)" ::: "memory"); __syncthreads();
    const int kbase = pg8::lds_byte(fr, 8 * fq);
    const int vbase = (fq >> 1) * 4096 + (4 * (fq & 1) + qq) * 32 + 8 * pp;
    float mref[2] = {0.f, 0.f}, l_reg[2] = {0.f, 0.f};
    f32x4 o[2][16];
#pragma unroll
    for (int qb = 0; qb < 2; ++qb)
#pragma unroll
        for (int vb = 0; vb < 16; ++vb) o[qb][vb] = (f32x4){0.f, 0.f, 0.f, 0.f};
    constexpr float PBIG = 1073741824.f;
#define A16_FADD(a_, b_) ((a_) + (b_))
#define A16_ROWRED(v_, OP) do { auto r16_ = __builtin_amdgcn_permlane16_swap(__float_as_uint(v_), __float_as_uint(v_), false, false); v_ = OP(__uint_as_float(r16_[0]), __uint_as_float(r16_[1])); \
        auto r32_ = __builtin_amdgcn_permlane32_swap(__float_as_uint(v_), __float_as_uint(v_), false, false); v_ = OP(__uint_as_float(r32_[0]), __uint_as_float(r32_[1])); } while (0)
    const int kaddr0 = (int)(unsigned)(uintptr_t)(L + A16_KOFF + kbase), vaddr0 = (int)(unsigned)(uintptr_t)(L + vbase);
#define A16_KRD(dst, off) asm volatile("ds_read_b128 %0, %1 offset:%2" : "=&v"(dst) : "v"(kaddr0), "i"(off) : "memory")
#define A16_VRD(dst, off) asm volatile("ds_read_b64_tr_b16 %0, %1 offset:%2" : "=&v"(dst) : "v"(vaddr0), "i"(off) : "memory")
#define A16_LW(n) do { asm volatile("s_waitcnt lgkmcnt(" #n ")" ::: "memory"); SBAR(); } while (0)
#define A16_KOFFS(BF, ks, kb) ((BF) * A16_K + ((ks) >> 1) * 8192 + (kb) * 2048 + ((ks) & 1) * 1024)
#define A16_KG(BF, g, x0, x1) do { A16_KRD(x0, A16_KOFFS(BF, (g) >> 1, 2 * ((g) & 1))); A16_KRD(x1, A16_KOFFS(BF, (g) >> 1, 2 * ((g) & 1) + 1)); } while (0)
#define A16_KM0(g, x0, x1) do { const f32x4 ctup[2] = {{mref[0], mref[0], mref[0], mref[0]}, {mref[1], mref[1], mref[1], mref[1]}};     \
        s[0][2 * ((g) & 1)] = __builtin_amdgcn_mfma_f32_16x16x32_bf16(x0, qf[0][(g) >> 1], ctup[0], 0, 0, 0); s[1][2 * ((g) & 1)] = __builtin_amdgcn_mfma_f32_16x16x32_bf16(x0, qf[1][(g) >> 1], ctup[1], 0, 0, 0); \
        s[0][2 * ((g) & 1) + 1] = __builtin_amdgcn_mfma_f32_16x16x32_bf16(x1, qf[0][(g) >> 1], ctup[0], 0, 0, 0); s[1][2 * ((g) & 1) + 1] = __builtin_amdgcn_mfma_f32_16x16x32_bf16(x1, qf[1][(g) >> 1], ctup[1], 0, 0, 0); } while (0)
#define A16_KM(g, x0, x1) do { \
        s[0][2 * ((g) & 1)] = __builtin_amdgcn_mfma_f32_16x16x32_bf16(x0, qf[0][(g) >> 1], s[0][2 * ((g) & 1)], 0, 0, 0); s[1][2 * ((g) & 1)] = __builtin_amdgcn_mfma_f32_16x16x32_bf16(x0, qf[1][(g) >> 1], s[1][2 * ((g) & 1)], 0, 0, 0); \
        s[0][2 * ((g) & 1) + 1] = __builtin_amdgcn_mfma_f32_16x16x32_bf16(x1, qf[0][(g) >> 1], s[0][2 * ((g) & 1) + 1], 0, 0, 0); s[1][2 * ((g) & 1) + 1] = __builtin_amdgcn_mfma_f32_16x16x32_bf16(x1, qf[1][(g) >> 1], s[1][2 * ((g) & 1) + 1], 0, 0, 0); } while (0)
#define A16_VOFFS(BF, i) ((BF) * A16_V + (4 * ((i) >> 4)) * 4096 + ((i) & 15) * 256)
#define A16_VG(BF, i, y0, y1) do { A16_VRD(y0, A16_VOFFS(BF, i)); A16_VRD(y1, A16_VOFFS(BF, i) + 2 * 4096); } while (0)
#define A16_VM(i, y0, y1) do { const bf16x8 vf_ = a16_cat(y0, y1); \
        o[0][(i) & 15] = __builtin_amdgcn_mfma_f32_16x16x32_bf16(pa[0][(i) >> 4], vf_, o[0][(i) & 15], 0, 0, 0); o[1][(i) & 15] = __builtin_amdgcn_mfma_f32_16x16x32_bf16(pa[1][(i) >> 4], vf_, o[1][(i) & 15], 0, 0, 0); } while (0)
#define A16_E1(i) do { s[(i) >> 3][((i) >> 2) & 1][(i) & 3] = __builtin_amdgcn_exp2f(s[(i) >> 3][((i) >> 2) & 1][(i) & 3]); ps[(i) >> 3] += s[(i) >> 3][((i) >> 2) & 1][(i) & 3]; } while (0)
#define A16_V2(BF, i) do {   \
        A16_VG(BF, (i) + 1, yb0, yb1); A16_LW(2); A16_VM(i, ya0, ya1); \
        if ((i) + 2 < 32) { A16_VG(BF, (i) + 2, ya0, ya1); A16_LW(2); } else A16_LW(0); A16_VM((i) + 1, yb0, yb1); } while (0)
#define A16_STEP(t, BF, FIRST) do { \
        if (__builtin_expect(!__all(l_reg[0] < PBIG && l_reg[1] < PBIG), 0)) {     \
            float al[2]; _Pragma("unroll") for (int qb = 0; qb < 2; ++qb) { float lm = l_reg[qb]; A16_ROWRED(lm, fmaxf); const float dl = lm > 1.f ? __builtin_amdgcn_logf(lm) : 0.f; al[qb] = __builtin_amdgcn_exp2f(-dl); l_reg[qb] *= al[qb]; mref[qb] -= dl; } \
            const int lr_ = mk_lane(), fr_ = lr_ & 15, fq_ = lr_ >> 4; if (fq_ == 0) { al_l[fr_] = al[0]; al_l[16 + fr_] = al[1]; } asm volatile("s_waitcnt lgkmcnt(0)" ::: "memory"); \
            _Pragma("unroll") for (int qb = 0; qb < 2; ++qb) _Pragma("unroll") for (int r = 0; r < 4; ++r) { const float a_ = al_l[16 * qb + 4 * fq_ + r]; _Pragma("unroll") for (int vb = 0; vb < 16; ++vb) o[qb][vb][r] *= a_; } } \
        f32x4 s[2][4]; bf16x8 xa0, xa1, xb0, xb1, xc0, xc1; float ps[2] = {0.f, 0.f};     \
        A16_KG(BF, 0, xa0, xa1); A16_KG(BF, 2, xb0, xb1); \
        A16_KG(BF, 4, xc0, xc1); A16_LW(4); A16_KM0(0, xa0, xa1); A16_KG(BF, 6, xa0, xa1); A16_LW(4); A16_KM(2, xb0, xb1); A16_KG(BF, 1, xb0, xb1); A16_LW(4); A16_KM(4, xc0, xc1); A16_KG(BF, 3, xc0, xc1); A16_LW(4); A16_KM(6, xa0, xa1);     \
        if ((t) * KVBLK + KVBLK - 1 > qlo) { const int lm_ = mk_lane(); _Pragma("unroll") for (int qb = 0; qb < 2; ++qb) { const int dq = qlo + 16 * qb + (lm_ & 15) - (t) * KVBLK - 4 * (lm_ >> 4); \
                _Pragma("unroll") for (int kb = 0; kb < 2; ++kb) _Pragma("unroll") for (int r = 0; r < 4; ++r) s[qb][kb][r] = (16 * kb + r > dq) ? -__builtin_inff() : s[qb][kb][r]; } } \
        A16_KG(BF, 5, xa0, xa1); A16_LW(4); A16_KM0(1, xb0, xb1); if (!(FIRST)) { A16_E1(0); A16_E1(1); A16_E1(2); A16_E1(3); }     \
        A16_KG(BF, 7, xb0, xb1); A16_LW(4); A16_KM(3, xc0, xc1); if (!(FIRST)) { A16_E1(4); A16_E1(5); A16_E1(6); A16_E1(7); }     \
        A16_LW(2); A16_KM(5, xa0, xa1); if (!(FIRST)) { A16_E1(8); A16_E1(9); A16_E1(10); A16_E1(11); }     \
        A16_LW(0); A16_KM(7, xb0, xb1); if (!(FIRST)) { A16_E1(12); A16_E1(13); A16_E1(14); A16_E1(15); }     \
        SBAR(); if ((t) + 1 < NT) A16_DMA(((t) + 1) * KVBLK, 1 - (BF)); SBAR(); \
        if ((t) * KVBLK + KVBLK - 1 > qlo) { const int lm_ = mk_lane(); _Pragma("unroll") for (int qb = 0; qb < 2; ++qb) { const int dq = qlo + 16 * qb + (lm_ & 15) - (t) * KVBLK - 4 * (lm_ >> 4); \
                _Pragma("unroll") for (int kb = 2; kb < 4; ++kb) _Pragma("unroll") for (int r = 0; r < 4; ++r) s[qb][kb][r] = (16 * kb + r > dq) ? -__builtin_inff() : s[qb][kb][r]; } } \
        if (FIRST) { _Pragma("unroll") for (int qb = 0; qb < 2; ++qb) {              \
                float pmax = s[qb][0][0]; _Pragma("unroll") for (int kb = 0; kb < 4; ++kb) _Pragma("unroll") for (int r = 0; r < 4; ++r) pmax = fmaxf(pmax, s[qb][kb][r]); \
                A16_ROWRED(pmax, fmaxf); \
                _Pragma("unroll") for (int kb = 0; kb < 4; ++kb) s[qb][kb] -= pmax; mref[qb] -= pmax; } \
            A16_E1(0); A16_E1(1); A16_E1(2); A16_E1(3); A16_E1(4); A16_E1(5); A16_E1(6); A16_E1(7); A16_E1(8); A16_E1(9); A16_E1(10); A16_E1(11); A16_E1(12); A16_E1(13); A16_E1(14); A16_E1(15); } \
        bf16x8 pa[2][2]; \
        _Pragma("unroll") for (int qb = 0; qb < 2; ++qb) { \
            _Pragma("unroll") for (int kb = 2; kb < 4; ++kb) _Pragma("unroll") for (int r = 0; r < 4; ++r) { s[qb][kb][r] = __builtin_amdgcn_exp2f(s[qb][kb][r]); ps[qb] += s[qb][kb][r]; } \
            l_reg[qb] += ps[qb];                                                    \
            _Pragma("unroll") for (int st = 0; st < 2; ++st) { u32x4 w = {cvtpk(s[qb][2 * st][0], s[qb][2 * st][1]), cvtpk(s[qb][2 * st][2], s[qb][2 * st][3]), cvtpk(s[qb][2 * st + 1][0], s[qb][2 * st + 1][1]), cvtpk(s[qb][2 * st + 1][2], s[qb][2 * st + 1][3])}; \
                pa[qb][st] = *reinterpret_cast<bf16x8*>(&w); } } \
        { s16x4 ya0, ya1, yb0, yb1, yc0, yc1; SBAR();     \
          A16_VG(BF, 0, ya0, ya1); A16_VG(BF, 1, yb0, yb1); \
          A16_VG(BF, 2, yc0, yc1); A16_LW(4); A16_VM(0, ya0, ya1); A16_VG(BF, 3, ya0, ya1); A16_LW(4); A16_VM(1, yb0, yb1); A16_VG(BF, 4, yb0, yb1); A16_LW(4); A16_VM(2, yc0, yc1); A16_VG(BF, 5, yc0, yc1); A16_LW(4); A16_VM(3, ya0, ya1); \
          A16_VG(BF, 6, ya0, ya1); A16_LW(4); A16_VM(4, yb0, yb1); A16_VG(BF, 7, yb0, yb1); A16_LW(4); A16_VM(5, yc0, yc1); A16_VG(BF, 8, yc0, yc1); A16_LW(4); A16_VM(6, ya0, ya1); A16_VG(BF, 9, ya0, ya1); A16_LW(4); A16_VM(7, yb0, yb1); \
          A16_VG(BF, 10, yb0, yb1); A16_LW(4); A16_VM(8, yc0, yc1); A16_VG(BF, 11, yc0, yc1); A16_LW(4); A16_VM(9, ya0, ya1); A16_VG(BF, 12, ya0, ya1); A16_LW(4); A16_VM(10, yb0, yb1); A16_VG(BF, 13, yb0, yb1); A16_LW(4); A16_VM(11, yc0, yc1); \
          A16_VG(BF, 14, yc0, yc1); A16_LW(4); A16_VM(12, ya0, ya1); A16_VG(BF, 15, ya0, ya1); A16_LW(4); A16_VM(13, yb0, yb1); A16_VG(BF, 16, yb0, yb1); A16_LW(4); A16_VM(14, yc0, yc1); A16_VG(BF, 17, yc0, yc1); A16_LW(4); A16_VM(15, ya0, ya1); \
          A16_VG(BF, 18, ya0, ya1); A16_LW(4); A16_VM(16, yb0, yb1); A16_VG(BF, 19, yb0, yb1); A16_LW(4); A16_VM(17, yc0, yc1); A16_VG(BF, 20, yc0, yc1); A16_LW(4); A16_VM(18, ya0, ya1); A16_VG(BF, 21, ya0, ya1); A16_LW(4); A16_VM(19, yb0, yb1); \
          A16_VG(BF, 22, yb0, yb1); A16_LW(4); A16_VM(20, yc0, yc1); A16_VG(BF, 23, yc0, yc1); A16_LW(4); A16_VM(21, ya0, ya1); A16_VG(BF, 24, ya0, ya1); A16_LW(4); A16_VM(22, yb0, yb1); A16_VG(BF, 25, yb0, yb1); A16_LW(4); A16_VM(23, yc0, yc1); \
          A16_VG(BF, 26, yc0, yc1); A16_LW(4); A16_VM(24, ya0, ya1); A16_VG(BF, 27, ya0, ya1); A16_LW(4); A16_VM(25, yb0, yb1); A16_VG(BF, 28, yb0, yb1); A16_LW(4); A16_VM(26, yc0, yc1); A16_VG(BF, 29, yc0, yc1); A16_LW(4); A16_VM(27, ya0, ya1); \
          A16_VG(BF, 30, ya0, ya1); A16_LW(4); A16_VM(28, yb0, yb1); A16_VG(BF, 31, yb0, yb1); A16_LW(4); A16_VM(29, yc0, yc1); A16_LW(2); A16_VM(30, ya0, ya1); A16_LW(0); A16_VM(31, yb0, yb1); } \
        asm volatile("s_waitcnt vmcnt(0)" ::: "memory"); __syncthreads(); } while (0)
    for (int t = 0; t < NT; t += 2) { A16_STEP(t, 0, (t) == 0); A16_STEP(t + 1, 1, false); }
#undef A16_STEP
#undef A16_V2
#undef A16_E1
#undef A16_VM
#undef A16_VG
#undef A16_VOFFS
#undef A16_KM
#undef A16_KM0
#undef A16_KG
#undef A16_KOFFS
#undef A16_LW
#undef A16_VRD
#undef A16_KRD
#undef A16_DMA
    const int le = mk_lane(), fre = le & 15, fqe = le >> 4;
    A16_ROWRED(l_reg[0], A16_FADD); A16_ROWRED(l_reg[1], A16_FADD);
    if (fqe == 0) { li_l[fre] = l_reg[0]; li_l[16 + fre] = l_reg[1]; } asm volatile("s_waitcnt lgkmcnt(0)" ::: "memory");
#pragma unroll
    for (int qb = 0; qb < 2; ++qb)
#pragma unroll
        for (int r = 0; r < 4; ++r) { const float rl = __builtin_amdgcn_rcpf(li_l[16 * qb + 4 * fqe + r]);
#pragma unroll
            for (int vb = 0; vb < 16; ++vb) o[qb][vb][r] *= rl; }
    u32x4* Xw = (u32x4*)cur.X + (size_t)wid * (16 * 64) + le;
    if (MODE == 0) {
#pragma unroll
        for (int qb = 0; qb < 2; ++qb)
#pragma unroll
            for (int v2 = 0; v2 < 8; ++v2) { u32x4 w = {cvtpk(o[qb][2 * v2][0], o[qb][2 * v2][1]), cvtpk(o[qb][2 * v2][2], o[qb][2 * v2][3]), cvtpk(o[qb][2 * v2 + 1][0], o[qb][2 * v2 + 1][1]), cvtpk(o[qb][2 * v2 + 1][2], o[qb][2 * v2 + 1][3])};
                Xw[(qb * 8 + v2) * 64] = w; }
    } else {
        const float lam = cur.lam;
#pragma unroll
        for (int qb = 0; qb < 2; ++qb)
#pragma unroll
            for (int v2 = 0; v2 < 8; ++v2) { const u32x4 a = Xw[(qb * 8 + v2) * 64];
#pragma unroll
                for (int e = 0; e < 4; ++e) { const unsigned w = a[e]; const int vb = 2 * v2 + (e >> 1), r0 = 2 * (e & 1);
                    o[qb][vb][r0] = __builtin_bit_cast(float, w << 16) - lam * o[qb][vb][r0]; o[qb][vb][r0 + 1] = __builtin_bit_cast(float, w & 0xffff0000u) - lam * o[qb][vb][r0 + 1]; } }
#pragma unroll
        for (int qb = 0; qb < 2; ++qb)
#pragma unroll
            for (int r = 0; r < 4; ++r) { float ss = 0.f;
#pragma unroll
                for (int vb = 0; vb < 16; ++vb) ss += o[qb][vb][r] * o[qb][vb][r];
#pragma unroll
                for (int k_ = 1; k_ < 16; k_ <<= 1) ss += __builtin_bit_cast(float, __builtin_amdgcn_ds_bpermute((le ^ k_) << 2, __builtin_bit_cast(int, ss)));
                const float rs_ = __builtin_amdgcn_rsqf(ss * (1.0f / 256.0f) + 1e-5f);
#pragma unroll
                for (int vb = 0; vb < 16; ++vb) o[qb][vb][r] *= rs_; }
        char* stg = lds_g + wid * (32 * 136 * 2);
#pragma unroll
        for (int hf = 0; hf < 2; ++hf) {
#pragma unroll
            for (int qb = 0; qb < 2; ++qb)
#pragma unroll
                for (int r = 0; r < 4; ++r)
#pragma unroll
                    for (int v8 = 0; v8 < 8; ++v8) { const float v = o[qb][8 * hf + v8][r]; unsigned u_ = __builtin_bit_cast(unsigned, v);
                        *(unsigned short*)(stg + ((16 * qb + 4 * fqe + r) * 136 + 16 * v8 + fre) * 2) = (unsigned short)((u_ + 0x7fffu + ((u_ >> 16) & 1u)) >> 16); }
            asm volatile("" ::: "memory");
#pragma unroll
            for (int j = 0; j < 8; ++j) { const int row = 4 * j + (le >> 4), ch = le & 15; const u32x4 w = *(const u32x4*)(stg + (row * 136 + ch * 8) * 2);
                *(u32x4*)(cur.RA + (size_t)(wid * QBLK + row) * 4096 + hf * 128 + ch * 8) = w; }
            asm volatile("" ::: "memory");
        }
        __syncthreads();
    }
}
#undef A16_ROWRED
#undef A16_FADD
}
constexpr int NWAVES = 8;
#ifndef MK_N_LAUNCHES
#define MK_N_LAUNCHES 1
#endif
constexpr int NPH = 17;
#ifndef MK_SP2
#define MK_SP2 true
#endif
#ifndef MK_ALIGN
#define MK_ALIGN true
#endif
#ifndef MK_EXTRA_BARRIERS
#define MK_EXTRA_BARRIERS 0
#endif
#ifndef MK_REPEAT_BARRIER
#define MK_REPEAT_BARRIER 0
#endif
#ifndef MK_NSTAT
#define MK_NSTAT 0
#endif
#ifndef MK_PROBE_COLDW
#define MK_PROBE_COLDW 0
#endif
#ifndef MK_FFN_SPLIT
#define MK_FFN_SPLIT 1
#endif
#ifndef MK_KVQ_SPLIT
#define MK_KVQ_SPLIT 0
#endif
#ifndef MK_REPEAT_MASK
#define MK_REPEAT_MASK 0
#endif
#ifndef MK_PHASE_MASK
#define MK_PHASE_MASK 0x1ffff
#endif
constexpr int N_LAUNCHES = MK_N_LAUNCHES;
constexpr int BATCH = 2, T = 8192, D = 4096, M = BATCH * T, FF = 11008;
constexpr size_t MiB = 1u << 20;
constexpr size_t WS_CTL = 0, CTL_ZERO_BYTES = 1 * MiB;
constexpr size_t WS_COS = 1 * MiB, WS_SIN = 5 * MiB, WS_PS = 9 * MiB, WS_RS = 13 * MiB;
constexpr size_t WS_WIN = 16 * MiB, WS_WRO = 144 * MiB, WS_WKVQ = 176 * MiB, WS_WDO = 272 * MiB, WS_WGU = 304 * MiB, WS_WDN = 648 * MiB;
constexpr size_t WS_XN = 820 * MiB, WS_RA = 948 * MiB, WS_Y = 1076 * MiB, WS_A = 1204 * MiB, WS_B = 1716 * MiB, WS_END = 2228 * MiB;
constexpr size_t WGU_BYTES = (size_t)2 * FF * D * 2, WDN_BYTES = (size_t)D * FF * 2;
constexpr int CW_BAR = 4096;
constexpr int LDS_BYTES = 147456, MISC_OFF = 139264;

#define GAS __attribute__((address_space(1)))
#define LAS __attribute__((address_space(3)))
typedef unsigned short bf16;
typedef unsigned v4u __attribute__((ext_vector_type(4)));
typedef unsigned v2u __attribute__((ext_vector_type(2)));
typedef float f32x4 __attribute__((ext_vector_type(4)));
typedef float f32x16 __attribute__((ext_vector_type(16)));
typedef short bf16x8 __attribute__((ext_vector_type(8)));
typedef short s16x4 __attribute__((ext_vector_type(4)));
#define LDS_WAIT() asm volatile("s_waitcnt lgkmcnt(0)" ::: "memory")
__device__ __forceinline__ unsigned f2bf(float f) { unsigned u = __builtin_bit_cast(unsigned, f); return (u + 0x7fffu + ((u >> 16) & 1u)) >> 16; }
__device__ __forceinline__ unsigned pk2(float lo, float hi) { return pg8::cvt_pk_bf16(lo, hi); }
__device__ __forceinline__ float bf_lo(unsigned w) { return __builtin_bit_cast(float, w << 16); }
__device__ __forceinline__ float bf_hi(unsigned w) { return __builtin_bit_cast(float, w & 0xffff0000u); }
__device__ __forceinline__ float wave_sum(float v) {
#pragma unroll
    for (int o = 1; o < 64; o <<= 1) v += __shfl_xor(v, o);
    return v;
}
#define XB_TMO      128
#define XB_XCNT(j)  (256  + 64 * (j))
#define XB_XSUB(j)  (1280 + 64 * (j))
#define XB_XGEN(j)  (2304 + 64 * (j))
#define XB_TOP      3328
#define XB_TOPGEN   3392
#define XCD_BAR_WORDS 3456
#define XB_SPIN_CAP (1u << 18)

__device__ __forceinline__ unsigned xb_ld(unsigned* p)              { return __hip_atomic_load(p, __ATOMIC_RELAXED, __HIP_MEMORY_SCOPE_AGENT); }
__device__ __forceinline__ unsigned xb_add(unsigned* p, unsigned v) { return __hip_atomic_fetch_add(p, v, __ATOMIC_RELAXED, __HIP_MEMORY_SCOPE_AGENT); }
__device__ __forceinline__ unsigned xb_xcc_id() { return (unsigned)__builtin_amdgcn_s_getreg((3 << 11) | 20) & 0xFu; }
#define XB_SPIN(cond, bar) do { unsigned _sp = 0; while (cond) { __builtin_amdgcn_s_sleep(1); \
    if ((++_sp & 255u) == 0u) { if (xb_ld(&(bar)[XB_TMO])) break; if (_sp > XB_SPIN_CAP) { atomicAdd(&(bar)[XB_TMO], 1u); break; } } } } while (0)

struct XcdBarrier {
    unsigned* bar; unsigned x;
    volatile LAS unsigned* st;
};

__device__ __forceinline__ XcdBarrier xcd_barrier_post(unsigned* bar, volatile LAS unsigned* st, bool is_t0  ) {
    XcdBarrier b; b.bar = bar; b.x = xb_xcc_id(); b.st = st;
    if (is_t0) (void)xb_add(&bar[XB_XCNT(b.x)], 1u);
    return b;
}
__device__ __forceinline__ void xcd_barrier_complete(unsigned* bar, unsigned x, unsigned& nloc, unsigned& nx) {
    const unsigned G = gridDim.x * gridDim.y * gridDim.z;
    unsigned sum, cnt, mine, sp = 0u;
    for (;;) {
        sum = 0u; cnt = 0u; mine = 0u;
#pragma unroll
        for (unsigned j = 0; j < 16; ++j) { const unsigned c = xb_ld(&bar[XB_XCNT(j)]); sum += c; cnt += (c > 0u) ? 1u : 0u; mine = (j == x) ? c : mine; }
        if (sum == G) break;
        __builtin_amdgcn_s_sleep(1);
        if ((++sp & 255u) == 0u) { if (xb_ld(&bar[XB_TMO])) break; if (sp > XB_SPIN_CAP) { atomicAdd(&bar[XB_TMO], 1u); break; } }
    }
    nloc = mine > 0u ? mine : 1u; nx = cnt > 0u ? cnt : 1u;
}

__device__ __forceinline__ void xcd_barrier(const XcdBarrier& b, bool is_t0) {
    asm volatile("s_waitcnt vmcnt(0)" ::: "memory");
    __syncthreads();
    if (is_t0) {
        unsigned* bar = b.bar;
        __builtin_amdgcn_s_waitcnt(0);
        unsigned nloc = b.st[0], nx = b.st[1];
        if (nloc == 0u) { xcd_barrier_complete(bar, b.x, nloc, nx); b.st[0] = nloc; b.st[1] = nx; }
        const unsigned old = xb_add(&bar[XB_XSUB(b.x)], 1u);
        const unsigned gen = old / nloc;
        if (old + 1u == (gen + 1u) * nloc) {
            __builtin_amdgcn_fence(__ATOMIC_RELEASE, "agent");
            asm volatile("s_waitcnt vmcnt(0)" ::: "memory");
            const unsigned og = xb_add(&bar[XB_TOP], 1u);
            const unsigned tg = og / nx;
            if (og + 1u == (tg + 1u) * nx) xb_add(&bar[XB_TOPGEN], 1u);
            else XB_SPIN(xb_ld(&bar[XB_TOPGEN]) == tg, bar);
            __builtin_amdgcn_fence(__ATOMIC_ACQUIRE, "agent");
            xb_add(&bar[XB_XGEN(b.x)], 1u);
            asm volatile("s_waitcnt vmcnt(0)" ::: "memory");
        } else {
            XB_SPIN(xb_ld(&bar[XB_XGEN(b.x)]) == gen, bar);
            __builtin_amdgcn_fence(__ATOMIC_ACQUIRE, "agent");
            asm volatile("s_waitcnt vmcnt(0)" ::: "memory");
        }
    }
    __syncthreads();
}
struct Args { const float* in[17]; float* out; unsigned char* ws; int ph_lo, ph_hi; float l2g[16]; float invf[128]; float lam_init, one_m_lam; };

__device__ __forceinline__ void transpose_item(const float* W, int K, int N, bf16* WT, int dst_row0, int dst_row1, const float* gain, int gmask, float gscale, LAS float* scr, int k0, int n0, int lane) {
    float v[64];
#pragma unroll
    for (int i = 0; i < 64; ++i) v[i] = __builtin_nontemporal_load(W + (size_t)(k0 + i) * N + n0 + lane);
#pragma unroll
    for (int i = 0; i < 64; ++i) scr[i * 65 + lane] = v[i];
    LDS_WAIT(); asm volatile("" ::: "memory");
    const int c = lane & 7;
    float g[8];
#pragma unroll
    for (int e = 0; e < 8; ++e) g[e] = gain ? gain[(k0 + 8 * c + e) & gmask] * gscale : 1.0f;
#pragma unroll
    for (int j = 0; j < 8; ++j) { const int n = (lane >> 3) + 8 * j; const LAS float* s = scr + (8 * c) * 65 + n;
        v4u o; o.x = pk2(s[0 * 65] * g[0], s[1 * 65] * g[1]); o.y = pk2(s[2 * 65] * g[2], s[3 * 65] * g[3]); o.z = pk2(s[4 * 65] * g[4], s[5 * 65] * g[5]); o.w = pk2(s[6 * 65] * g[6], s[7 * 65] * g[7]);
        const int dr = (n < 32 ? dst_row0 : dst_row1 - 32) + n;
        if (MK_BTILED) *(v4u*)(WT + (((size_t)(dr >> 8) * (K >> 6) + (k0 >> 6)) * 256 + (dr & 255)) * 64 + 8 * c) = o;
        else *(v4u*)(WT + (size_t)dr * K + k0 + 8 * c) = o; }
    LDS_WAIT(); asm volatile("" ::: "memory");
}
__device__ __forceinline__ int transpose_dst(int n0, int row_off, int mode) {
    if (mode == 1) { const int sel = n0 >= FF ? 1 : 0, j = n0 - sel * FF; return 256 * (j >> 7) + 128 * sel + (j & 127); }
    return row_off + n0;
}
__device__ __forceinline__ void transpose_job(const float* W, int K, int N, bf16* WT, int row_off, int mode, const float* gain, int gmask, float gscale, LAS float* scr, int gw, int NGW, int lane) {
    const int nblk = N / 64, nitems = (K / 64) * nblk;
    for (int it = gw; it < nitems; it += NGW) { const int kb = it / nblk, nb = it - kb * nblk, n0 = 64 * nb;
        transpose_item(W, K, N, WT, transpose_dst(n0, row_off, mode), transpose_dst(n0 + 32, row_off, mode), gain, gmask, gscale, scr, 64 * kb, n0, lane); }
}
__device__ __forceinline__ void rms_row_to_bf16(const float* xrow, bf16* orow, float* rsp, int lane) {
    const f32x4* xr = (const f32x4*)xrow + lane;
    f32x4 v[16]; float s = 0.f;
#pragma unroll
    for (int j = 0; j < 16; ++j) { v[j] = xr[64 * j]; s += (v[j].x * v[j].x + v[j].y * v[j].y) + (v[j].z * v[j].z + v[j].w * v[j].w); }
    const float rstd = 1.0f / sqrtf(wave_sum(s) * (1.0f / D) + 1e-6f);
    v2u* o8 = (v2u*)orow + lane;
#pragma unroll
    for (int j = 0; j < 16; ++j) { v2u w; w.x = pk2(v[j].x * rstd, v[j].y * rstd); w.y = pk2(v[j].z * rstd, v[j].w * rstd); o8[64 * j] = w; }
    if (lane == 0) *rsp = rstd;
}
template <int MODE> __device__ __forceinline__ void norm_res_rows(const bf16* Yb, const float* PSb, const float* xin, bf16* HBb, const float* gpost, float* RSb, float* outb, int gw, int NGW, int lane) {
    f32x4 g[16];
#pragma unroll
    for (int j = 0; j < 16; ++j) g[j] = ((const f32x4*)gpost + lane)[64 * j];
    for (int m = gw; m < M; m += NGW) {
        const float rstd = 1.0f / sqrtf(wave_sum(PSb[(size_t)m * 64 + lane]) * (1.0f / D) + 1e-6f);
        const v2u* yr = (const v2u*)(Yb + (size_t)m * D) + lane; v2u* hr = (v2u*)(HBb + (size_t)m * D) + lane;
        const float hsc = MODE == 0 ? 1.0f / RSb[m] : 1.0f;
        f32x4 v[16]; float s = 0.f;
#pragma unroll
        for (int j = 0; j < 16; ++j) { const v2u y = __builtin_nontemporal_load(yr + 64 * j); f32x4 h;
            { const v2u hh = hr[64 * j]; h.x = bf_lo(hh.x) * hsc; h.y = bf_hi(hh.x) * hsc; h.z = bf_lo(hh.y) * hsc; h.w = bf_hi(hh.y) * hsc; }
            h.x += bf_lo(y.x) * rstd * g[j].x; h.y += bf_hi(y.x) * rstd * g[j].y; h.z += bf_lo(y.y) * rstd * g[j].z; h.w += bf_hi(y.y) * rstd * g[j].w;
            v[j] = h; s += (h.x * h.x + h.y * h.y) + (h.z * h.z + h.w * h.w); }
        if (MODE == 2) {
#pragma unroll
            for (int j = 0; j < 16; ++j) __builtin_nontemporal_store(v[j], (f32x4*)(outb + (size_t)m * D) + lane + 64 * j);
        } else {
#pragma unroll
            for (int j = 0; j < 16; ++j) { v2u w; w.x = pk2(v[j].x, v[j].y); w.y = pk2(v[j].z, v[j].w); hr[64 * j] = w; }
            const float r2 = 1.0f / sqrtf(wave_sum(s) * (1.0f / D) + 1e-6f); if (lane == 0) RSb[m] = r2; }
    }
}
__device__ __forceinline__ s16x4 tr4(LAS unsigned char* p) { return __builtin_amdgcn_ds_read_tr16_b64_v4i16((LAS s16x4*)p); }
__device__ __forceinline__ bf16x8 cat8(s16x4 a, s16x4 b) { return (bf16x8){a[0], a[1], a[2], a[3], b[0], b[1], b[2], b[3]}; }
constexpr int R12_KS = 136, R12_VS = 72, R12_KB = 128 * R12_KS * 2, R12_VB = 128 * R12_VS * 2, R12_BUF = R12_KB + R12_VB;
static_assert(2 * R12_BUF + 2 * 16384 <= MISC_OFF, "state-phase LDS map");
__device__ __forceinline__ void ret_state_phase(LAS unsigned char* lds, const bf16* Kg, const bf16* Vg, bf16* ST, const float (&l2gtab)[16], int G, int blk, int tid) {
    const int wid = __builtin_amdgcn_readfirstlane(tid >> 6), lane = tid & 63, wk = wid & 3, wv = wid >> 2, l31 = lane & 31, hh = lane >> 5;
    const int q = (lane & 15) >> 2, p = lane & 3, b16 = (lane >> 4) & 1;
    const int ka_off = ((8 * hh + q) * R12_KS + 32 * wk + 16 * b16 + 4 * p) * 2, vb_off = ((8 * hh + q) * R12_VS + 32 * wv + 16 * b16 + 4 * p) * 2;
    for (int u0 = blk; u0 < 256; u0 += G) {
        const int u = (((u0 & 7) * 4 + ((u0 >> 3) >> 3)) << 3) | ((u0 >> 3) & 7);
        const int bh = u >> 3, b = bh >> 4, h = bh & 15, vq = (u >> 1) & 3, kh = u & 1;
        const float l2g = l2gtab[h], cd = __builtin_amdgcn_exp2f(l2g * 128.0f);
        const bf16* Kp = Kg + ((size_t)b * 8192) * 4096 + h * 256 + kh * 128 + (size_t)(tid >> 4) * 4096 + (tid & 15) * 8;
        const bf16* Vp = Vg + ((size_t)b * 8192) * 4096 + h * 256 + vq * 64 + (size_t)(tid >> 3) * 4096 + (tid & 7) * 8;
        bf16* Sb = ST + ((size_t)bh * 64) * 65536 + (size_t)(vq * 64) * 256 + kh * 128;
        v4u krA[4], vrA[2], krB[4], vrB[2];
#define R12_LOAD(kr, vr, cc) do { _Pragma("unroll") for (int j = 0; j < 4; ++j) kr[j] = *(const v4u*)(Kp + (size_t)((cc) * 128 + 32 * j) * 4096); \
        _Pragma("unroll") for (int j = 0; j < 2; ++j) vr[j] = *(const v4u*)(Vp + (size_t)((cc) * 128 + 64 * j) * 4096); } while (0)
        R12_LOAD(krA, vrA, 0); R12_LOAD(krB, vrB, 1);
        f32x16 acc;
#pragma unroll
        for (int r = 0; r < 16; ++r) acc[r] = 0.f;
#define R12_STEP(kr, vr, c) do { \
            LAS unsigned char* Kb = lds + ((c) & 1) * R12_BUF; LAS unsigned char* Vb = Kb + R12_KB; \
            _Pragma("unroll") for (int j = 0; j < 4; ++j) *(LAS v4u*)(Kb + (((tid >> 4) + 32 * j) * R12_KS + (tid & 15) * 8) * 2) = kr[j]; \
            _Pragma("unroll") for (int j = 0; j < 2; ++j) { const int row = (tid >> 3) + 64 * j; const float dec = __builtin_amdgcn_exp2f(l2g * (float)(127 - row)); const v4u x = vr[j]; v4u w; \
                w.x = pk2(bf_lo(x.x) * dec, bf_hi(x.x) * dec); w.y = pk2(bf_lo(x.y) * dec, bf_hi(x.y) * dec); w.z = pk2(bf_lo(x.z) * dec, bf_hi(x.z) * dec); w.w = pk2(bf_lo(x.w) * dec, bf_hi(x.w) * dec); \
                *(LAS v4u*)(Vb + (row * R12_VS + (tid & 7) * 8) * 2) = w; } \
            if ((c) + 2 < 64) R12_LOAD(kr, vr, (c) + 2); \
              \
            { LAS unsigned char* Tb = lds + 2 * R12_BUF + ((c) & 1) * 16384; const int vl = 32 * wv + l31; \
              _Pragma("unroll") for (int g = 0; g < 4; ++g) { const int k0 = 32 * wk + 8 * g + 4 * hh; v2u w; w.x = pk2(acc[4 * g], acc[4 * g + 1]); w.y = pk2(acc[4 * g + 2], acc[4 * g + 3]); \
                  *(LAS v2u*)(Tb + vl * 256 + (((k0 >> 3) ^ (vl & 15)) << 4) + ((k0 & 4) << 1)) = w; } \
              __syncthreads(); \
              _Pragma("unroll") for (int j = 0; j < 2; ++j) { const int ci = tid + 512 * j, row = ci >> 4, ch = ci & 15; const v4u w = *(const LAS v4u*)(Tb + row * 256 + ((ch ^ (row & 15)) << 4)); \
                  *(v4u*)(Sb + (size_t)(c) * 65536 + (size_t)row * 256 + ch * 8) = w; } } \
            _Pragma("unroll") for (int r = 0; r < 16; ++r) acc[r] *= cd; \
            _Pragma("unroll") for (int ts = 0; ts < 8; ++ts) { \
                const bf16x8 a = cat8(tr4(Kb + ka_off + (16 * ts) * R12_KS * 2), tr4(Kb + ka_off + (16 * ts + 4) * R12_KS * 2)); \
                const bf16x8 bb = cat8(tr4(Vb + vb_off + (16 * ts) * R12_VS * 2), tr4(Vb + vb_off + (16 * ts + 4) * R12_VS * 2)); \
                acc = __builtin_amdgcn_mfma_f32_32x32x16_bf16(a, bb, acc, 0, 0, 0); } } while (0)
        for (int c = 0; c < 64; c += 2) { R12_STEP(krA, vrA, c); R12_STEP(krB, vrB, c + 1); }
#undef R12_STEP
#undef R12_LOAD
        __syncthreads();
    }
}
constexpr int R3_KS = 264, R3_SS = 136, R3_SOFF = 0, R3_STOFF = 8 * 16 * R3_SS * 2, R3_B1 = R3_STOFF + 64 * R3_KS * 2;
static_assert(R3_B1 >= 128 * R3_KS * 2 && R3_B1 + 128 * R3_KS * 2 <= MISC_OFF, "retention LDS map");
__device__ __forceinline__ void ret_out_phase(LAS unsigned char* lds, const bf16* Qg, const bf16* Kg, const bf16* Vg, const bf16* Gg, const bf16* ST, bf16* RA, const float (&l2gtab)[16], int G, int blk, int tid) {
    const int wid = __builtin_amdgcn_readfirstlane(tid >> 6);
    LAS unsigned char* B0 = lds; LAS unsigned char* SB = lds + R3_SOFF + wid * (16 * R3_SS * 2); LAS unsigned char* STB = lds + R3_STOFF; LAS unsigned char* B1 = lds + R3_B1;
    for (int u = blk; u < 2048; u += G) {
        int lane = tid & 63; asm volatile("" : "+v"(lane));
        const int fr = lane & 15, fq = lane >> 4, q = (lane & 15) >> 2, p = lane & 3, lrow = 2 * wid + (lane >> 5), lch = lane & 31;
        const int bh = u >> 6, c = u & 63, b = bh >> 4, h = bh & 15;
        const float l2g = l2gtab[h];
        const size_t row0 = (size_t)b * 8192 + (size_t)c * 128;
        const bf16* Qp = Qg + row0 * 4096 + h * 256; const bf16* Kp = Kg + row0 * 4096 + h * 256; const bf16* Vp = Vg + row0 * 4096 + h * 256;
        const bf16* STp = ST + ((size_t)bh * 64 + c) * 65536;
        bf16x8 qf[8];
        { v4u tk[8], tv[8];
#pragma unroll
          for (int j = 0; j < 8; ++j) tk[j] = *(const v4u*)(Kp + (size_t)(lrow + 16 * j) * 4096 + lch * 8);
#pragma unroll
          for (int j = 0; j < 8; ++j) tv[j] = *(const v4u*)(Vp + (size_t)(lrow + 16 * j) * 4096 + lch * 8);
#pragma unroll
          for (int ks = 0; ks < 8; ++ks) qf[ks] = *(const bf16x8*)(Qp + (size_t)(16 * wid + fr) * 4096 + 32 * ks + 8 * fq);
#pragma unroll
          for (int j = 0; j < 8; ++j) *(LAS v4u*)(B0 + ((lrow + 16 * j) * R3_KS + lch * 8) * 2) = tk[j];
#pragma unroll
          for (int j = 0; j < 8; ++j) *(LAS v4u*)(B1 + ((lrow + 16 * j) * R3_KS + lch * 8) * 2) = tv[j]; }
        __syncthreads();
        f32x4 s[8];
#pragma unroll
        for (int j = 0; j < 8; ++j) { s[j] = (f32x4){0.f, 0.f, 0.f, 0.f};
#pragma unroll
            for (int ks = 0; ks < 8; ++ks) { const bf16x8 kf = *(const LAS bf16x8*)(B0 + ((16 * j + fr) * R3_KS + 32 * ks + 8 * fq) * 2); s[j] = __builtin_amdgcn_mfma_f32_16x16x32_bf16(qf[ks], kf, s[j], 0, 0, 0); } }
        v4u stA[4], stB[4];
#define R3_LDST(st, qq) do { _Pragma("unroll") for (int j = 0; j < 4; ++j) st[j] = *(const v4u*)(STp + (size_t)((qq) * 64 + lrow + 16 * j) * 256 + lch * 8); } while (0)
#define R3_WRST(st) do { _Pragma("unroll") for (int j = 0; j < 4; ++j) *(LAS v4u*)(STB + ((lrow + 16 * j) * R3_KS + lch * 8) * 2) = st[j]; } while (0)
        R3_LDST(stA, 0); R3_LDST(stB, 1);
        __syncthreads();
        { int d0 = 16 * wid + 4 * fq - fr; asm volatile("" : "+v"(d0));
          const float eb = l2g * (float)d0;
#pragma unroll
          for (int j = 0; j < 8; ++j)
#pragma unroll
            for (int r = 0; r < 4; ++r) {
                const float v = s[j][r] * __builtin_amdgcn_exp2f(fmaf(l2g, (float)(r - 16 * j), eb)); unsigned sg; asm volatile("v_ashrrev_i32 %0, 31, %1" : "=v"(sg) : "v"(d0 + (r - 16 * j)));
                *(LAS unsigned short*)(SB + ((4 * fq + r) * R3_SS + 16 * j + fr) * 2) = (unsigned short)(f2bf(v) & ~sg); } }
        R3_WRST(stA);
        f32x4 o[16];
#pragma unroll
        for (int nt = 0; nt < 16; ++nt) o[nt] = (f32x4){0.f, 0.f, 0.f, 0.f};
#pragma unroll
        for (int vq = 0; vq < 4; ++vq) {
            if (vq == 0) R3_LDST(stA, 2); if (vq == 1) R3_LDST(stB, 3);
            __syncthreads();
#pragma unroll
            for (int n4 = 0; n4 < 4; ++n4)
#pragma unroll
                for (int ks = 0; ks < 8; ++ks) { const bf16x8 sf = *(const LAS bf16x8*)(STB + ((16 * n4 + fr) * R3_KS + 32 * ks + 8 * fq) * 2); o[4 * vq + n4] = __builtin_amdgcn_mfma_f32_16x16x32_bf16(qf[ks], sf, o[4 * vq + n4], 0, 0, 0); }
            if (vq < 3) { __syncthreads(); if (vq == 0) R3_WRST(stB); if (vq == 1) R3_WRST(stA); if (vq == 2) R3_WRST(stB); }
        }
#undef R3_LDST
#undef R3_WRST
        v4u g8[8];
#pragma unroll
        for (int j = 0; j < 8; ++j) g8[j] = *(const v4u*)(Gg + (row0 + 16 * wid + 2 * j + (lane >> 5)) * 4096 + h * 256 + (lane & 31) * 8);
#pragma unroll
        for (int r = 0; r < 4; ++r) { const float dq = __builtin_amdgcn_exp2f(l2g * (float)(16 * wid + 4 * fq + r + 1));
#pragma unroll
            for (int nt = 0; nt < 16; ++nt) o[nt][r] *= dq; }
#pragma unroll
        for (int ts = 0; ts < 4; ++ts) {
            { const bf16x8 sf = *(const LAS bf16x8*)(SB + (fr * R3_SS + 32 * ts + 8 * fq) * 2);
#pragma unroll
                for (int nt = 0; nt < 16; ++nt) { LAS unsigned char* vp = B1 + ((32 * ts + 8 * fq + q) * R3_KS + 16 * nt + 4 * p) * 2;
                    const bf16x8 vf = cat8(tr4(vp), tr4(vp + 4 * R3_KS * 2)); o[nt] = __builtin_amdgcn_mfma_f32_16x16x32_bf16(sf, vf, o[nt], 0, 0, 0); } } }
        __syncthreads();
        LAS unsigned char* EST = B1 + wid * (16 * R3_KS * 2);
#pragma unroll
        for (int j = 0; j < 8; ++j) *(LAS v4u*)(EST + ((2 * j + (lane >> 5)) * R3_KS + (lane & 31) * 8) * 2) = g8[j];
        asm volatile("" ::: "memory");
#pragma unroll
        for (int r = 0; r < 4; ++r) { float sm = 0.f;
#pragma unroll
            for (int nt = 0; nt < 16; ++nt) sm += o[nt][r];
            sm += __shfl_xor(sm, 1); sm += __shfl_xor(sm, 2); sm += __shfl_xor(sm, 4); sm += __shfl_xor(sm, 8);
            const float mu = sm * (1.0f / 256.0f); float vs = 0.f;
#pragma unroll
            for (int nt = 0; nt < 16; ++nt) { const float d = o[nt][r] - mu; vs += d * d; }
            vs += __shfl_xor(vs, 1); vs += __shfl_xor(vs, 2); vs += __shfl_xor(vs, 4); vs += __shfl_xor(vs, 8);
            const float rstd = 1.0f / sqrtf(vs * (1.0f / 256.0f) + 1e-5f);
            LAS unsigned short* gp = (LAS unsigned short*)(EST + ((4 * fq + r) * R3_KS + fr) * 2);
#pragma unroll
            for (int nt = 0; nt < 16; ++nt) { const float g = __builtin_bit_cast(float, (unsigned)gp[16 * nt] << 16); gp[16 * nt] = (unsigned short)f2bf((o[nt][r] - mu) * rstd * g); } }
        asm volatile("" ::: "memory");
#pragma unroll
        for (int j = 0; j < 8; ++j) { const v4u w = *(const LAS v4u*)(EST + ((2 * j + (lane >> 5)) * R3_KS + (lane & 31) * 8) * 2);
            *(v4u*)(RA + (row0 + 16 * wid + 2 * j + (lane >> 5)) * 4096 + h * 256 + (lane & 31) * 8) = w; }
        __syncthreads();
    }
}
#ifndef MK_ATT16
#define MK_ATT16 1
#endif
#if MK_ATT16
#define MK_ATT_BLOCK att::attn16_block
#else
#define MK_ATT_BLOCK att::attn2_block
#endif
__device__ __forceinline__ att::Ref2 att_ref2(int bh, int i, int qb, const bf16* QH, const bf16* KH, const bf16* VH, float* X, bf16* RA, float lam) {
    const int hm = bh * 2 + i, b = bh >> 4, h = bh & 15;
    att::Ref2 r;
    r.Q = QH + ((size_t)hm * 8192 + (size_t)qb * 256) * 128; r.K = KH + (size_t)hm * 8192 * 128; r.V0 = VH + (size_t)(bh * 2) * 8192 * 128; r.V1 = VH + (size_t)(bh * 2 + 1) * 8192 * 128;
    r.X = X; r.RA = RA + ((size_t)b * 8192 + (size_t)qb * 256) * 4096 + h * 256; r.lam = lam; r.P0 = qb * 256;
    return r;
}
__device__ __forceinline__ void attn_phase(char* lds, const bf16* QH, const bf16* KH, const bf16* VH, float* XS, bf16* RA, const float* lamp, float lam_init, int G, int blk, int wave_id) {
    const int lane = mk_lane();
    float a = lamp[lane] * lamp[128 + lane] + lamp[64 + lane] * lamp[192 + lane], c = lamp[256 + lane] * lamp[384 + lane] + lamp[320 + lane] * lamp[448 + lane];
    const float lam = __builtin_bit_cast(float, __builtin_amdgcn_readfirstlane(__builtin_bit_cast(int, __expf(wave_sum(a)) - __expf(wave_sum(c)) + lam_init)));
    float* X = XS + (size_t)blk * (8 * 32 * 64 * 4);
    for (int L = blk; L < 512; L += G) {
        const int xcd = L & 7, k = L >> 3, bh = xcd * 4 + (k >> 4), x = k & 15;
        { const att::Ref2 cur = att_ref2(bh, 0, 31 - x, QH, KH, VH, X, RA, lam); MK_ATT_BLOCK<0>(cur, lds, wave_id); }
        { const att::Ref2 cur = att_ref2(bh, 0, x, QH, KH, VH, X + 8 * 16 * 64 * 4, RA, lam); MK_ATT_BLOCK<0>(cur, lds, wave_id); }
        { const att::Ref2 cur = att_ref2(bh, 1, 31 - x, QH, KH, VH, X, RA, lam); MK_ATT_BLOCK<1>(cur, lds, wave_id); }
        { const att::Ref2 cur = att_ref2(bh, 1, x, QH, KH, VH, X + 8 * 16 * 64 * 4, RA, lam); MK_ATT_BLOCK<1>(cur, lds, wave_id); }
    }
}
extern __shared__ __attribute__((aligned(16))) unsigned char lds_raw[];
struct Ctx { LAS unsigned char* lds; unsigned char* ws; int wave, G, blk, gw, NGW; };
template <int P> __device__ __forceinline__ void run_phase(const Ctx& c, const Args& a) {
    const int tid = c.wave * 64 + mk_lane();
    unsigned char* ws = c.ws; const int G = c.G, blk = c.blk, gw = c.gw, NGW = c.NGW, lane = tid & 63; LAS unsigned char* lds = c.lds;
    bf16* const W_in = (bf16*)(ws + WS_WIN); bf16* const W_ro = (bf16*)(ws + WS_WRO); bf16* const W_kvq = (bf16*)(ws + WS_WKVQ); bf16* const W_do = (bf16*)(ws + WS_WDO);
    bf16* const W_gu = (bf16*)(ws + WS_WGU); bf16* const W_dn = (bf16*)(ws + WS_WDN);
    bf16* const XN = (bf16*)(ws + WS_XN); bf16* const RA = (bf16*)(ws + WS_RA); bf16* const Y = (bf16*)(ws + WS_Y); float* const PS = (float*)(ws + WS_PS);
    bf16* const QKVG = (bf16*)(ws + WS_A); bf16* const KVQ = (bf16*)(ws + WS_A);
    bf16* const STT = (bf16*)(ws + WS_B); bf16* const HB = (bf16*)(ws + WS_B); float* const AO = (float*)(ws + WS_B);
    constexpr size_t TSZ = (size_t)M * 4096, HSZ = (size_t)64 * 8192 * 128;
    float* const RS = (float*)(ws + WS_RS);
    if constexpr (P == 0) {
        LAS float* scr = (LAS float*)(lds + c.wave * 16896);
        transpose_job(a.in[3], D, 4 * D, W_in, 0, 0, a.in[1], 0x7fffffff, 1.0f, scr, gw, NGW, lane);
        transpose_job(a.in[4], D, D, W_ro, 0, 0, nullptr, 0, 1.0f, scr, gw, NGW, lane);
        transpose_job(a.in[6], D, 2 * D, W_kvq, 0, 0, a.in[5], 0x7fffffff, 1.0f, scr, gw, NGW, lane);
        transpose_job(a.in[9], D, D, W_kvq, 2 * D, 0, a.in[7], 0x7fffffff, 1.4426950408889634f * att::SCALE, scr, gw, NGW, lane);
        transpose_job(a.in[12], D, D, W_do, 0, 0, a.in[11], 255, a.one_m_lam, scr, gw, NGW, lane);
        for (int l = 0; l < 2; ++l) {
            transpose_job(a.in[15] + (size_t)l * D * 2 * FF, D, 2 * FF, W_gu + (size_t)l * 2 * FF * D, 0, 1, a.in[13] + l * D, 0x7fffffff, 1.0f, scr, gw, NGW, lane);
            transpose_job(a.in[16] + (size_t)l * FF * D, FF, D, W_dn + (size_t)l * D * FF, 0, 0, nullptr, 0, 1.0f, scr, gw, NGW, lane); }
        for (int m = gw; m < M; m += NGW) rms_row_to_bf16(a.in[0] + (size_t)m * D, XN + (size_t)m * D, RS + m, lane);
    }
    if constexpr (P == 1) {
        pg8::Gemm g{XN, W_in, M, 4 * D, D}; pg8::EpiQKVG E{QKVG};
#if MK_NSTAT
        pg8::NStatOrder S; S.init(M, 4 * D, G, blk); pg8::gemm_phase<pg8::EpiQKVG, pg8::NStatOrder, MK_ALIGN, MK_SP2>(lds, g, S, E, c.wave); }
#else
        pg8::StaticOrder S; S.init(M, 4 * D, G, blk); pg8::gemm_phase<pg8::EpiQKVG, pg8::StaticOrder, MK_ALIGN, MK_SP2>(lds, g, S, E, c.wave); }
#endif
    if constexpr (P == 2) ret_state_phase(lds, QKVG + TSZ, QKVG + 2 * TSZ, STT, a.l2g, G, blk, tid);
    if constexpr (P == 3) ret_out_phase(lds, QKVG, QKVG + TSZ, QKVG + 2 * TSZ, QKVG + 3 * TSZ, STT, RA, a.l2g, G, blk, tid);
    if constexpr (P == 4 || P == 12) { pg8::Gemm g{RA, P == 4 ? W_ro : W_do, M, D, D}; pg8::StaticOrder S; S.init(M, D, G, blk); pg8::EpiYSS E{Y, PS};
        pg8::gemm_phase<pg8::EpiYSS, pg8::StaticOrder, MK_ALIGN, MK_SP2>(lds, g, S, E, c.wave); }
    if constexpr (P == 5)  norm_res_rows<0>(Y, PS, a.in[0], XN, a.in[2], RS, nullptr, gw, NGW, lane);
    if constexpr (P == 8)  norm_res_rows<1>(Y, PS, nullptr, XN, a.in[14], RS, nullptr, gw, NGW, lane);
    if constexpr (P == 13) norm_res_rows<1>(Y, PS, nullptr, XN, a.in[8], RS, nullptr, gw, NGW, lane);
    if constexpr (P == 16) norm_res_rows<2>(Y, PS, nullptr, XN, a.in[14] + D, nullptr, a.out, gw, NGW, lane);
    constexpr bool L1 = (P == 14 || P == 15 || P == 114); constexpr int MH = MK_FFN_SPLIT ? M / 2 : M, PMH = M / 512;
    if constexpr (P == 6 || P == 14 || ((P == 7 || P == 15) && MK_FFN_SPLIT)) {
        if constexpr (P == 7 || P == 15) { pg8::Gemm g{HB, W_dn + (L1 ? (size_t)D * FF : 0), M, D, FF}; pg8::StaticOrder S; S.init(MH, D, G, blk, 0); pg8::EpiYSS E{Y, PS};
            pg8::gemm_phase<pg8::EpiYSS, pg8::StaticOrder, MK_ALIGN, MK_SP2, MK_HTILED != 0>(lds, g, S, E, c.wave); }
        pg8::Gemm g{XN, W_gu + (L1 ? (size_t)2 * FF * D : 0), M, 2 * FF, D}; pg8::StaticOrder S; S.init(MH, 2 * FF, G, blk, (P == 7 || P == 15) ? PMH : 0); pg8::EpiSwiGLU E{HB, RS};
        pg8::gemm_phase<pg8::EpiSwiGLU, pg8::StaticOrder, MK_ALIGN, MK_SP2>(lds, g, S, E, c.wave); }
    if constexpr (((P == 7 || P == 15) && !MK_FFN_SPLIT) || P == 106 || P == 114) { pg8::Gemm g{HB, W_dn + (L1 ? (size_t)D * FF : 0), M, D, FF}; pg8::StaticOrder S; S.init(MH, D, G, blk, MK_FFN_SPLIT ? PMH : 0); pg8::EpiYSS E{Y, PS};
        pg8::gemm_phase<pg8::EpiYSS, pg8::StaticOrder, MK_ALIGN, MK_SP2, MK_HTILED != 0>(lds, g, S, E, c.wave); }
    if constexpr (P == 9) { pg8::Gemm g{XN, W_kvq, M, 3 * D, D}; pg8::StaticOrder S; S.init(M, 3 * D, G, blk); pg8::EpiKVQ E{KVQ, RS};
        pg8::gemm_phase<pg8::EpiKVQ, pg8::StaticOrder, MK_ALIGN, MK_SP2>(lds, g, S, E, c.wave); }
    if constexpr (P == 10) attn_phase((char*)lds_raw, KVQ + 2 * HSZ, KVQ, KVQ + HSZ, AO, RA, a.in[10], a.lam_init, G, blk, c.wave);
}
__global__ void __launch_bounds__(NWAVES * 64, 2) mk_fwd(Args a) {
    Ctx c; c.lds = (LAS unsigned char*)lds_raw; c.ws = a.ws;
    volatile LAS unsigned* MISC = (volatile LAS unsigned*)(c.lds + MISC_OFF);
    c.wave = __builtin_amdgcn_readfirstlane((int)threadIdx.x >> 6); c.G = gridDim.x; c.blk = blockIdx.x;
    c.gw = c.blk * NWAVES + c.wave; c.NGW = c.G * NWAVES;
    for (int u = threadIdx.x; u < (LDS_BYTES - MISC_OFF) / 4; u += NWAVES * 64) ((LAS unsigned*)(c.lds + MISC_OFF))[u] = 0u;
    __syncthreads();
    XcdBarrier bar; bar.bar = (unsigned*)(a.ws + WS_CTL) + CW_BAR; bar.x = 0; bar.st = nullptr;
    if (N_LAUNCHES == 1) bar = xcd_barrier_post((unsigned*)(a.ws + WS_CTL) + CW_BAR, MISC + 8, threadIdx.x == 0);
    const int lo = a.ph_lo, hi = a.ph_hi;
#define IN(k) (((MK_PHASE_MASK >> (k)) & 1) && lo <= (k) && (k) < hi)
    static_assert(N_LAUNCHES == 1 || !MK_FFN_SPLIT, "the one-launch-per-phase bring-up build has no barrier inside a launch: build it with MK_FFN_SPLIT 0");
#define RUNX(k, kk) do { if (MK_FFN_SPLIT && IN(k)) { run_phase<kk>(c, a); if (N_LAUNCHES == 1 && IN((k) + 1)) xcd_barrier(bar, c.wave == 0 && mk_lane() == 0); } } while (0)
#define RUN(k) do { if (IN(k)) { run_phase<k>(c, a); if constexpr ((MK_REPEAT_MASK >> (k)) & 1) { if (MK_REPEAT_BARRIER) xcd_barrier(bar, c.wave == 0 && mk_lane() == 0); run_phase<k>(c, a); } } if (N_LAUNCHES == 1 && IN(k) && IN((k) + 1)) { xcd_barrier(bar, c.wave == 0 && mk_lane() == 0); for (int xb_ = 0; xb_ < MK_EXTRA_BARRIERS; ++xb_) xcd_barrier(bar, c.wave == 0 && mk_lane() == 0); } } while (0)
    RUN(0); RUN(1); RUN(2); RUN(3); RUN(4); RUN(5); RUN(6);
    RUN(7); RUNX(7, 106); RUN(8); RUN(9); RUN(10);
    RUN(12); RUN(13); RUN(14); RUN(15); RUNX(15, 114); RUN(16);
#undef IN
#undef RUN
#undef RUNX
}

extern "C" void kernel_launch(void* const* d_in, const int* in_sizes, int n_in, void* d_out, int out_size, void* d_ws, size_t ws_size, hipStream_t stream) {
    static int grid = 0;
    if (grid == 0) {
        if (n_in != 17 || out_size != M * D || ws_size < WS_END) { fprintf(stderr, "kernel_launch: unexpected problem (n_in %d, out %d, ws %zu)\n", n_in, out_size, ws_size); grid = -1; return; }
        int dev = 0, cus = 0;
        if (hipGetDevice(&dev) != hipSuccess || hipDeviceGetAttribute(&cus, hipDeviceAttributeMultiprocessorCount, dev) != hipSuccess) { grid = -1; return; }
        if (hipFuncSetAttribute((const void*)mk_fwd, hipFuncAttributeMaxDynamicSharedMemorySize, LDS_BYTES) != hipSuccess) { fprintf(stderr, "kernel_launch: hipFuncSetAttribute failed\n"); grid = -1; return; }
        int per_cu = 0;
        if (hipOccupancyMaxActiveBlocksPerMultiprocessor(&per_cu, (const void*)mk_fwd, NWAVES * 64, LDS_BYTES) != hipSuccess || per_cu < 1) fprintf(stderr, "kernel_launch: occupancy query says %d\n", per_cu);
        (void)hipGetLastError();
        grid = cus;
    }
    if (grid < 0) return;
    (void)hipMemsetAsync((char*)d_ws + WS_CTL, 0, CTL_ZERO_BYTES, stream);
    Args a{};
    for (int i = 0; i < 17; ++i) a.in[i] = (const float*)d_in[i];
    a.out = (float*)d_out; a.ws = (unsigned char*)d_ws;
    for (int h = 0; h < 16; ++h) a.l2g[h] = (float)(log1p(-exp2(-5.0 - (double)h)) / log(2.0));
    for (int j = 0; j < 128; ++j) a.invf[j] = (float)(1.0 / pow(10000.0, (double)j / 127.0));
    const double li = 0.8 - 0.6 * exp(-0.3 * 1.0);
    a.lam_init = (float)li; a.one_m_lam = (float)(1.0 - li);
    if (N_LAUNCHES == 1) { a.ph_lo = 0; a.ph_hi = NPH; hipLaunchKernelGGL(mk_fwd, dim3(grid), dim3(NWAVES * 64), LDS_BYTES, stream, a); }
    else for (int p = 0; p < NPH; ++p) { a.ph_lo = p; a.ph_hi = p + 1; hipLaunchKernelGGL(mk_fwd, dim3(grid), dim3(NWAVES * 64), LDS_BYTES, stream, a); }
}
```

```cpp
#include <hip/hip_runtime.h>
#include <cstdio>
#include <cstdint>
#include <cmath>
#ifndef MK_BTILED
#define MK_BTILED 1
#endif
#ifndef MK_HTILED
#define MK_HTILED 0
#endif
#ifndef MK_FRESH
#define MK_FRESH 1
#endif
#ifndef MK_PN_ROT
#define MK_PN_ROT 0
#endif
__device__ __forceinline__ int mk_lane() { int l; asm volatile("v_mbcnt_lo_u32_b32 %0, -1, 0\n\tv_mbcnt_hi_u32_b32 %0, -1, %0" : "=v"(l)); return l; }
namespace pg8 {
#define PG8_LAS __attribute__((address_space(3)))
typedef unsigned short bf16_t;
typedef short bf16x8 __attribute__((ext_vector_type(8)));
typedef float f32x4 __attribute__((ext_vector_type(4)));
typedef unsigned u32x4 __attribute__((ext_vector_type(4)));
constexpr int BM = 256, BK = 64, HALF = 128, HTB = HALF * BK * 2  , STAGE_BYTES = 8 * HTB, NXCD = 8, WGM = 8;

__host__ __device__ __forceinline__ int lds_byte(int r, int c) { const int st = (r >> 4) * 2 + (c >> 5), rr = r & 15, cc = c & 31, ob = rr * 64 + cc * 2; return st * 1024 + (ob ^ (((ob >> 9) & 1) << 5)); }
__host__ __device__ __forceinline__ void stage_rc(int b, int& R, int& C) { const int st = b / 1024, sb = b % 1024, swz = sb ^ (((sb >> 9) & 1) << 5); R = (st >> 1) * 16 + swz / 64; C = (st & 1) * 32 + (swz % 64) / 2; }
__host__ __device__ __forceinline__ int perm32(int rho) { const int n = rho >> 4, i = rho & 15; return 8 * (i >> 2) + 4 * n + (i & 3); }

struct Unit { int pm, pn; };
struct Gemm { const bf16_t* A; const bf16_t* Bt; int M, N, K; };

struct StaticOrder {
    int nM, nN, nwg, G, c, pm0;
    __host__ __device__ void init(int M, int N, int G_, int c_, int pm0_ = 0) { nM = M / BM; nN = N / BM; nwg = nM * nN; G = G_; c = c_; pm0 = pm0_; }
    __host__ __device__ bool next(int i, Unit& u) const {
        const long L = (long)i * G + c; if (L >= nwg) return false;
        int wgid = (int)L; { const int q = nwg / NXCD, r = nwg % NXCD, xcd = wgid % NXCD, off = wgid / NXCD; wgid = (xcd < r ? xcd * (q + 1) : r * (q + 1) + (xcd - r) * q) + off; }
        const int nig = WGM * nN, gid = wgid / nig, fm = gid * WGM, gsz = (nM - fm) < WGM ? (nM - fm) : WGM;
        u.pm = pm0 + fm + ((wgid % nig) % gsz); u.pn = (wgid % nig) / gsz;
#if MK_PN_ROT
        { int p = u.pn + (c & 7) * (nN / 8); u.pn = p >= nN ? p - nN : p; }
#endif
        return true;
    }
    __device__ __forceinline__ void a_ready(const Unit&) const {}
    __device__ __forceinline__ void done(const Unit&) const {}
};

struct NStatOrder {
    int nM, nN, G, c;
    __host__ __device__ void init(int M, int N, int G_, int c_) { nM = M / BM; nN = N / BM; G = G_; c = c_; }
    __host__ __device__ bool next(int i, Unit& u) const {
        const int x = c & 7, cc = c >> 3, per = nN >> 3, rpb = nM >> 3, nb = per >> 2;
        if (i >= nb * rpb || cc >= 32) return false;
        const int hb = i / rpb, pmb = i - hb * rpb;
        u.pm = 8 * pmb + (cc & 7); u.pn = x * per + 4 * hb + (cc >> 3); return true;
    }
    __device__ __forceinline__ void a_ready(const Unit&) const {}
    __device__ __forceinline__ void done(const Unit&) const {}
};

__device__ __forceinline__ unsigned cvt_pk_bf16(float lo, float hi) { unsigned r; asm volatile("v_cvt_pk_bf16_f32 %0, %1, %2" : "=v"(r) : "v"(lo), "v"(hi)); return r; }
typedef float f32x2 __attribute__((ext_vector_type(2)));
#ifndef MK_P1_FRESH
#define MK_P1_FRESH 1
#endif
#ifndef MK_NT_STORES
#define MK_NT_STORES 0
#endif
#if MK_NT_STORES
#define PG8_ST16(p, v) __builtin_nontemporal_store((v), (u32x4*)(p))
#else
#define PG8_ST16(p, v) (*(u32x4*)(p) = (v))
#endif
__device__ __forceinline__ float silu_f(float v) { return v * __builtin_amdgcn_rcpf(1.0f + __builtin_amdgcn_exp2f(-1.4426950408889634f * v)); }
struct EpiQKVG {
    static constexpr bool PERM = true, AFTER_DRAIN = false; static constexpr bool RS_LDS = false; static constexpr int NST = 16; static constexpr bool FRESH_OK = MK_P1_FRESH != 0;
    bf16_t* O;
    __device__ __forceinline__ void operator()(const f32x4 (&acc)[2][2][4][2], const Unit& u, int wr, int wc, int fr, int fq, const PG8_LAS float* rsl) const {
        asm volatile("" : "+v"(fr), "+v"(fq));
        const int row0 = u.pm * BM + wr * 64 + fr, t = u.pn >> 4, colt = (u.pn & 15) * BM;
        bf16_t* base = O + (size_t)t * ((size_t)16384 * 4096);
        const int col0 = colt + wc * 32 + 8 * fq;
        float ivf[2][4];
#pragma unroll
        for (int bj = 0; bj < 2; ++bj)
#pragma unroll
            for (int j = 0; j < 4; ++j) ivf[bj][j] = __builtin_amdgcn_exp2f((float)(64 * bj + 16 * wc + 4 * fq + j) * (-13.287712379549449f / 127.0f));
#pragma unroll
        for (int ai = 0; ai < 2; ++ai)
#pragma unroll
            for (int m = 0; m < 4; ++m) { const int row = row0 + ai * HALF + m * 16, pos = row & 8191; bf16_t* rowp = base + (size_t)row * 4096 + col0;
#pragma unroll
                for (int bj = 0; bj < 2; ++bj) { f32x4 v0 = acc[ai][bj][m][0], v1 = acc[ai][bj][m][1];
                    if (t < 2) { f32x4 c, s;
#pragma unroll
                        for (int j = 0; j < 4; ++j) { const float ang = (float)pos * ivf[bj][j], rev = ang * 0.15915494309189535f, frc = __builtin_amdgcn_fractf(rev); c[j] = __builtin_amdgcn_cosf(frc); s[j] = __builtin_amdgcn_sinf(frc); }
                        const float sc = (t == 1) ? 0.0625f : 1.0f;
                        f32x4 r0, r1;
                        r0[0] = (v0[0] * c[0] - v0[1] * s[0]) * sc; r0[1] = (v0[0] * s[0] + v0[1] * c[0]) * sc;
                        r0[2] = (v0[2] * c[1] - v0[3] * s[1]) * sc; r0[3] = (v0[2] * s[1] + v0[3] * c[1]) * sc;
                        r1[0] = (v1[0] * c[2] - v1[1] * s[2]) * sc; r1[1] = (v1[0] * s[2] + v1[1] * c[2]) * sc;
                        r1[2] = (v1[2] * c[3] - v1[3] * s[3]) * sc; r1[3] = (v1[2] * s[3] + v1[3] * c[3]) * sc;
                        v0 = r0; v1 = r1; }
                    else if (t == 3) {
#pragma unroll
                        for (int j = 0; j < 4; ++j) { v0[j] = silu_f(v0[j]); v1[j] = silu_f(v1[j]); } }
                    u32x4 w; w.x = cvt_pk_bf16(v0[0], v0[1]); w.y = cvt_pk_bf16(v0[2], v0[3]); w.z = cvt_pk_bf16(v1[0], v1[1]); w.w = cvt_pk_bf16(v1[2], v1[3]);
                    PG8_ST16(rowp + bj * HALF, w); } }
    }
};
struct EpiYSS {
    static constexpr bool PERM = true, AFTER_DRAIN = false, RS_LDS = false; static constexpr int NST = 16; static constexpr bool FRESH_OK = true;
    bf16_t* Y; float* PS;
    __device__ __forceinline__ void operator()(const f32x4 (&acc)[2][2][4][2], const Unit& u, int wr, int wc, int fr, int fq, const PG8_LAS float* rsl) const {
        const int row0 = u.pm * BM + wr * 64 + fr, col0 = u.pn * BM + wc * 32 + 8 * fq;
#pragma unroll
        for (int ai = 0; ai < 2; ++ai)
#pragma unroll
            for (int m = 0; m < 4; ++m) { const int row = row0 + ai * HALF + m * 16; bf16_t* rowp = Y + (size_t)row * 4096 + col0; float ss = 0.f;
#pragma unroll
                for (int bj = 0; bj < 2; ++bj) { const f32x4 v0 = acc[ai][bj][m][0], v1 = acc[ai][bj][m][1];
                    ss += (v0[0] * v0[0] + v0[1] * v0[1]) + (v0[2] * v0[2] + v0[3] * v0[3]) + (v1[0] * v1[0] + v1[1] * v1[1]) + (v1[2] * v1[2] + v1[3] * v1[3]);
                    u32x4 w; w.x = cvt_pk_bf16(v0[0], v0[1]); w.y = cvt_pk_bf16(v0[2], v0[3]); w.z = cvt_pk_bf16(v1[0], v1[1]); w.w = cvt_pk_bf16(v1[2], v1[3]);
                    PG8_ST16(rowp + bj * HALF, w); }
                ss += __shfl_xor(ss, 16); ss += __shfl_xor(ss, 32);
                if (fq == 0) PS[(size_t)row * 64 + u.pn * 4 + wc] = ss; }
    }
};
struct EpiSwiGLU {
    static constexpr bool PERM = true, AFTER_DRAIN = false, RS_LDS = true; static constexpr int NST = 8; static constexpr bool FRESH_OK = true;
    bf16_t* Hh; const float* rs;
    __device__ __forceinline__ void operator()(const f32x4 (&acc)[2][2][4][2], const Unit& u, int wr, int wc, int fr, int fq, const PG8_LAS float* rsl) const {
        const int row0 = u.pm * BM + wr * 64 + fr, col0 = u.pn * HALF + wc * 32 + 8 * fq;
#pragma unroll
        for (int ai = 0; ai < 2; ++ai)
#pragma unroll
            for (int m = 0; m < 4; ++m) { const int row = row0 + ai * HALF + m * 16; const float r1 = rsl[row & 255];
                f32x4 h0, h1;
#pragma unroll
                for (int j = 0; j < 4; ++j) { h0[j] = silu_f(acc[ai][0][m][0][j] * r1) * (acc[ai][1][m][0][j] * r1); h1[j] = silu_f(acc[ai][0][m][1][j] * r1) * (acc[ai][1][m][1][j] * r1); }
                u32x4 w; w.x = cvt_pk_bf16(h0[0], h0[1]); w.y = cvt_pk_bf16(h0[2], h0[3]); w.z = cvt_pk_bf16(h1[0], h1[1]); w.w = cvt_pk_bf16(h1[2], h1[3]);
                if (MK_HTILED) PG8_ST16(Hh + (((size_t)u.pm * 172 + (col0 >> 6)) * 256 + (row & 255)) * 64 + (col0 & 63), w);
                else PG8_ST16(Hh + (size_t)row * 11008 + col0, w);
#ifdef MK_PROBE_DUPSTORE
                PG8_ST16(Hh + (size_t)268435456 + (size_t)row * 11008 + col0, w);
#endif
                }
    }
};
struct EpiKVQ {
    static constexpr bool PERM = true, AFTER_DRAIN = false, RS_LDS = true; static constexpr int NST = 16; static constexpr bool FRESH_OK = true;
    bf16_t* O; const float* rs;
    __device__ __forceinline__ void operator()(const f32x4 (&acc)[2][2][4][2], const Unit& u, int wr, int wc, int fr, int fq, const PG8_LAS float* rsl) const {
        const int row0 = u.pm * BM + wr * 64 + fr, t = u.pn >> 4, hp = u.pn & 15;
        bf16_t* base = O + (size_t)t * ((size_t)64 * 8192 * 128) + wc * 32 + 8 * fq;
#pragma unroll
        for (int ai = 0; ai < 2; ++ai)
#pragma unroll
            for (int m = 0; m < 4; ++m) { const int row = row0 + ai * HALF + m * 16, b = row >> 13, s = row & 8191; const float r1 = rsl[row & 255];
#pragma unroll
                for (int bj = 0; bj < 2; ++bj) { const f32x4 v0 = acc[ai][bj][m][0] * r1, v1 = acc[ai][bj][m][1] * r1;
                    u32x4 w; w.x = cvt_pk_bf16(v0[0], v0[1]); w.y = cvt_pk_bf16(v0[2], v0[3]); w.z = cvt_pk_bf16(v1[0], v1[1]); w.w = cvt_pk_bf16(v1[2], v1[3]);
                    PG8_ST16(base + ((size_t)(b * 32 + 2 * hp + bj) * 8192 + s) * 128, w); } }
    }
};
template <class Epi, class Sched, bool ALIGN_EPI = false, bool SP2 = false, bool ATILED = false  >
__device__ __forceinline__ void gemm_phase(PG8_LAS unsigned char* lds, const Gemm g, const Sched& S, const Epi& E, int wave_id  ) {
    const int lane = mk_lane(), wid = wave_id, tid = wid * 64 + lane, wr = wid >> 2, wc = wid & 3, fr = lane & 15, fq = lane >> 4;
    const int K = g.K, nt = K / BK;
    unsigned voffA[2], voffB[2];
#pragma unroll
    for (int i = 0; i < 2; ++i) { int R, C; stage_rc(tid * 16 + i * 8192, R, C); const int Rb = Epi::PERM ? ((R & ~31) + perm32(R & 31)) : R;
        voffA[i] = ATILED ? (unsigned)(R * BK + C) * 2u : (unsigned)(R * K + C) * 2u; voffB[i] = MK_BTILED ? (unsigned)(Rb * BK + C) * 2u : (unsigned)(Rb * K + C) * 2u; }
    const size_t kstep = (size_t)(BK * 2);
    const size_t hstep = (size_t)HALF * K * 2;
    const size_t tstep = 2 * hstep;
    const size_t kstepA = ATILED ? (size_t)(BM * BK * 2) : kstep, hstepA = ATILED ? (size_t)(HALF * BK * 2) : hstep;
    const size_t kstepB = MK_BTILED ? (size_t)(BM * BK * 2) : kstep, hstepB = MK_BTILED ? (size_t)(HALF * BK * 2) : hstep;
    const unsigned ldsw = (unsigned)wid * 1024u;
    const int aoff = lds_byte(wr * 64 + fr, fq * 8), boff = lds_byte(wc * 32 + fr, fq * 8);
#define PG8_SA(b, h) (((b) * 2 + (h)) * HTB)
#define PG8_SB(b, h) ((4 + (b) * 2 + (h)) * HTB)
#ifndef MK_B_AUX
#define MK_B_AUX 0
#endif
#define PG8_STAGE(bufoff, gbase, voff) do { _Pragma("unroll") for (int _i = 0; _i < 2; ++_i) \
        __builtin_amdgcn_global_load_lds((const unsigned*)((const char*)(gbase) + (voff)[_i]), (PG8_LAS unsigned*)(lds + (bufoff) + ldsw + _i * 8192), 16, 0, ((bufoff) >= 4 * HTB) ? MK_B_AUX : 0); } while (0)
#define PG8_LDA(dst, b, h) do { _Pragma("unroll") for (int m = 0; m < 4; ++m) _Pragma("unroll") for (int k = 0; k < 2; ++k) dst[m][k] = *(const PG8_LAS bf16x8*)(lds + PG8_SA(b, h) + aoff + m * 2048 + k * 1024); } while (0)
#define PG8_LDB(dst, b, h) do { _Pragma("unroll") for (int n = 0; n < 2; ++n) _Pragma("unroll") for (int k = 0; k < 2; ++k) dst[n][k] = *(const PG8_LAS bf16x8*)(lds + PG8_SB(b, h) + boff + n * 2048 + k * 1024); } while (0)
#define PG8_MMA(ai, bj, At, Bt) do { __builtin_amdgcn_s_setprio(1); _Pragma("unroll") for (int m = 0; m < 4; ++m) _Pragma("unroll") for (int n = 0; n < 2; ++n) _Pragma("unroll") for (int k = 0; k < 2; ++k) \
        acc[ai][bj][m][n] = __builtin_amdgcn_mfma_f32_16x16x32_bf16(Bt[n][k], At[m][k], acc[ai][bj][m][n], 0, 0, 0); __builtin_amdgcn_s_setprio(0); } while (0)
#define PG8_WAIT_V(n) asm volatile("s_waitcnt vmcnt(" #n ")" ::: "memory")
#define PG8_WAIT_VN(n) asm volatile("s_waitcnt vmcnt(%0)" :: "i"(n) : "memory")
#define PG8_WAIT_L(n) asm volatile("s_waitcnt lgkmcnt(" #n ")" ::: "memory")
#define PG8_BAR __builtin_amdgcn_s_barrier()
#define PG8_SCHED __builtin_amdgcn_sched_barrier(0)
    Unit cur, nxt; int ui = 0;
    if (!S.next(0, cur)) return;
    f32x4 acc[2][2][4][2];
#pragma unroll
    for (int a = 0; a < 2; ++a)
#pragma unroll
        for (int b = 0; b < 2; ++b)
#pragma unroll
            for (int m = 0; m < 4; ++m)
#pragma unroll
                for (int n = 0; n < 2; ++n) acc[a][b][m][n] = (f32x4){0.f, 0.f, 0.f, 0.f};
    bf16x8 At[4][2], B0[2][2], B1[2][2];
    const char* cA = (const char*)g.A + (size_t)cur.pm * tstep; const char* cB = (const char*)g.Bt + (size_t)cur.pn * tstep;
    S.a_ready(cur);
#define PG8_RS_DMA(pm_, slot_) do { if constexpr (Epi::RS_LDS) { if (wid == 0) { unsigned lo_ = (unsigned)lane * 16u; asm volatile("" : "+v"(lo_));     \
        __builtin_amdgcn_global_load_lds((const unsigned*)((const char*)(E.rs + (size_t)(pm_) * BM) + lo_), (PG8_LAS unsigned*)(lds + STAGE_BYTES + (slot_) * 1024), 16, 0, 0); } } } while (0)
    PG8_RS_DMA(cur.pm, 0);
    if constexpr (SP2) {
        PG8_STAGE(PG8_SB(0, 0), cB, voffB); PG8_STAGE(PG8_SB(0, 1), cB + hstepB, voffB); PG8_STAGE(PG8_SA(0, 0), cA, voffA); PG8_STAGE(PG8_SA(0, 1), cA + hstepA, voffA);
        if (wr == 1) PG8_BAR;
        PG8_WAIT_V(2); PG8_BAR;
        PG8_STAGE(PG8_SB(1, 0), cB + kstepB, voffB); PG8_STAGE(PG8_SA(1, 0), cA + kstepA, voffA); PG8_STAGE(PG8_SB(1, 1), cB + hstepB + kstepB, voffB);
        PG8_WAIT_V(6); PG8_BAR;
    } else {
        PG8_STAGE(PG8_SB(0, 0), cB, voffB); PG8_STAGE(PG8_SA(0, 0), cA, voffA); PG8_STAGE(PG8_SB(0, 1), cB + hstepB, voffB); PG8_STAGE(PG8_SA(0, 1), cA + hstepA, voffA);
        if (wr == 1) PG8_BAR;
        PG8_WAIT_V(4); PG8_BAR;
        PG8_STAGE(PG8_SB(1, 0), cB + kstepB, voffB); PG8_STAGE(PG8_SA(1, 0), cA + kstepA, voffA); PG8_STAGE(PG8_SB(1, 1), cB + hstepB + kstepB, voffB);
        PG8_WAIT_V(6); PG8_BAR;
    }
#define PG8_ITER_SP2(DO_A11, NWAIT) do { \
              \
            PG8_LDB(B0, 0, 0); PG8_LDB(B1, 0, 1); PG8_SCHED; PG8_LDA(At, 0, 0); if (DO_A11) PG8_STAGE(PG8_SA(1, 1), a1 + hstepA, voffA); \
            PG8_WAIT_VN(NWAIT); PG8_WAIT_L(0); PG8_BAR; PG8_MMA(0, 0, At, B0); PG8_MMA(0, 1, At, B1); PG8_BAR; PG8_SCHED; \
              \
            PG8_LDA(At, 0, 1); PG8_STAGE(PG8_SB(0, 0), b2, voffB); PG8_STAGE(PG8_SB(0, 1), b2 + hstepB, voffB); PG8_STAGE(PG8_SA(0, 0), a2, voffA); \
            PG8_WAIT_VN(NWAIT); PG8_WAIT_L(0); PG8_BAR; PG8_MMA(1, 0, At, B0); PG8_MMA(1, 1, At, B1); PG8_BAR; PG8_SCHED; \
              \
            PG8_LDB(B0, 1, 0); PG8_LDB(B1, 1, 1); PG8_SCHED; PG8_LDA(At, 1, 0); PG8_STAGE(PG8_SA(0, 1), a2 + hstepA, voffA); \
            PG8_WAIT_VN(NWAIT); PG8_WAIT_L(0); PG8_BAR; PG8_MMA(0, 0, At, B0); PG8_MMA(0, 1, At, B1); PG8_BAR; PG8_SCHED; \
              \
            PG8_LDA(At, 1, 1); PG8_STAGE(PG8_SB(1, 0), b3, voffB); PG8_STAGE(PG8_SB(1, 1), b3 + hstepB, voffB); PG8_STAGE(PG8_SA(1, 0), a3, voffA); \
            PG8_WAIT_V(8); PG8_WAIT_L(0); PG8_BAR; PG8_MMA(1, 0, At, B0); PG8_MMA(1, 1, At, B1); PG8_BAR; PG8_SCHED; } while (0)
    for (;;) {
        const bool has_next = S.next(ui + 1, nxt);
        const char* nA = has_next ? (const char*)g.A + (size_t)nxt.pm * tstep : cA; const char* nB = has_next ? (const char*)g.Bt + (size_t)nxt.pn * tstep : cB;
        int t0 = 0;
        if constexpr (SP2 && ALIGN_EPI && MK_FRESH && Epi::FRESH_OK) { if (ui > 0) {
            const char* a1 = cA + kstepA; const char* a2 = cA + 2 * kstepA; const char* b2 = cB + 2 * kstepB; const char* a3 = a2 + kstepA; const char* b3 = b2 + kstepB; (void)a1;
            PG8_ITER_SP2(false, 8 + Epi::NST); t0 = 2; } }
        for (int t = t0; t < nt; t += 2) {
            const bool last = (t == nt - 2);
            const char* a1 = cA + (size_t)(t + 1) * kstepA;
            const char* a2 = last ? nA : cA + (size_t)(t + 2) * kstepA; const char* b2 = last ? nB : cB + (size_t)(t + 2) * kstepB;
            const char* a3 = a2 + kstepA; const char* b3 = b2 + kstepB;
            if (last && has_next) S.a_ready(nxt);
            if constexpr (SP2) {
            PG8_ITER_SP2(true, 8);
            } else {
            PG8_LDB(B0, 0, 0); PG8_SCHED; PG8_LDA(At, 0, 0); PG8_STAGE(PG8_SA(1, 1), a1 + hstepA, voffA);
            PG8_WAIT_L(8); PG8_BAR; PG8_WAIT_L(0); PG8_MMA(0, 0, At, B0); PG8_BAR; PG8_SCHED;
            PG8_LDB(B1, 0, 1); PG8_STAGE(PG8_SB(0, 0), b2, voffB);
            PG8_BAR; PG8_WAIT_L(0); PG8_MMA(0, 1, At, B1); PG8_BAR;
            PG8_LDA(At, 0, 1); PG8_STAGE(PG8_SA(0, 0), a2, voffA);
            PG8_BAR; PG8_WAIT_L(0); PG8_MMA(1, 0, At, B0); PG8_BAR; PG8_SCHED;
            PG8_STAGE(PG8_SB(0, 1), b2 + hstepB, voffB);
            PG8_WAIT_V(6); PG8_BAR; PG8_MMA(1, 1, At, B1); PG8_BAR;
            PG8_LDB(B0, 1, 0); PG8_SCHED; PG8_LDA(At, 1, 0); PG8_STAGE(PG8_SA(0, 1), a2 + hstepA, voffA);
            PG8_WAIT_L(8); PG8_BAR; PG8_WAIT_L(0); PG8_MMA(0, 0, At, B0); PG8_BAR; PG8_SCHED;
            PG8_LDB(B1, 1, 1); PG8_STAGE(PG8_SB(1, 0), b3, voffB);
            PG8_BAR; PG8_WAIT_L(0); PG8_MMA(0, 1, At, B1); PG8_BAR;
            PG8_LDA(At, 1, 1); PG8_STAGE(PG8_SA(1, 0), a3, voffA);
            PG8_BAR; PG8_WAIT_L(0); PG8_MMA(1, 0, At, B0); PG8_BAR; PG8_SCHED;
            PG8_STAGE(PG8_SB(1, 1), b3 + hstepB, voffB);
            PG8_WAIT_V(6); PG8_BAR; PG8_MMA(1, 1, At, B1); PG8_BAR;
            }
        }
        if constexpr (ALIGN_EPI) { if (wr == 0) PG8_BAR; }
        if (has_next) PG8_RS_DMA(nxt.pm, (ui + 1) & 1);
        if constexpr (SP2 && ALIGN_EPI && MK_FRESH && Epi::FRESH_OK) { if (has_next) PG8_STAGE(PG8_SA(1, 1), nA + kstepA + hstepA, voffA); asm volatile("" ::: "memory"); PG8_SCHED; }
        if constexpr (!Epi::AFTER_DRAIN) { E(acc, cur, wr, wc, fr, fq, (const PG8_LAS float*)(lds + STAGE_BYTES + (ui & 1) * 1024)); S.done(cur); }
        if (!has_next) break;
#pragma unroll
        for (int a = 0; a < 2; ++a)
#pragma unroll
            for (int b = 0; b < 2; ++b)
#pragma unroll
                for (int m = 0; m < 4; ++m)
#pragma unroll
                    for (int n = 0; n < 2; ++n) acc[a][b][m][n] = (f32x4){0.f, 0.f, 0.f, 0.f};
        cur = nxt; cA = nA; cB = nB; ++ui;
        if constexpr (ALIGN_EPI) { if (wr == 1) PG8_BAR; }
    }
    PG8_WAIT_V(0);
    if constexpr (!ALIGN_EPI) { if (wr == 0) PG8_BAR; }
    PG8_BAR;
    if constexpr (Epi::AFTER_DRAIN) { E.fused(acc, cur, wr, wc, fr, fq, lds, wid, lane); S.done(cur); }
#undef PG8_SA
#undef PG8_SB
#undef PG8_STAGE
#undef PG8_LDA
#undef PG8_LDB
#undef PG8_MMA
#undef PG8_RS_DMA
#undef PG8_ITER_SP2
#undef PG8_WAIT_V
#undef PG8_WAIT_VN
#undef PG8_WAIT_L
#undef PG8_BAR
#undef PG8_SCHED
}
}
namespace att {
constexpr int D = 128; constexpr float THR = 8.f; constexpr bool WSKIP = false;
constexpr float SCALE = 0.08838834764831845f;
constexpr int NW = 8, QBLK = 32, KVBLK = 64, QB = NW * QBLK;
constexpr int SHM_V = KVBLK * D * 2, SHM_K = KVBLK * D * 2;
constexpr int LDS_BYTES = 2 * SHM_V + 2 * SHM_K + NW * 64 * 4;

typedef short bf16x8 __attribute__((ext_vector_type(8)));
typedef short s16x4 __attribute__((ext_vector_type(4)));
typedef float f32x16 __attribute__((ext_vector_type(16)));
typedef float f32x4 __attribute__((ext_vector_type(4)));
typedef unsigned u32x4 __attribute__((ext_vector_type(4)));
template <class A, class Bt> struct same_t { static constexpr bool v = false; };
template <class A> struct same_t<A, A> { static constexpr bool v = true; };

#define KSWZ(row, colB) ((row) * 256 + ((colB) ^ (((row) & 7) << 4)))
#define SBAR() __builtin_amdgcn_sched_barrier(0)
__device__ __forceinline__ int v_st(int k, int c) { const int kk = (k & ~0xC) | ((k & 4) << 1) | ((k & 8) >> 1); return ((kk >> 3) * 4 + (c >> 5)) * 512 + ((kk & 7) * 32 + (c & 31)) * 2; }
__device__ __forceinline__ int v_rd_base(int lane) { return ((lane & 3) << 3) | (((lane >> 2) & 3) << 6) | (((lane >> 4) & 1) << 5) | (((lane >> 5) & 1) << 8); }
constexpr int v_rd_off(int d0, int ks, int half) { return d0 * 512 + ks * 4096 + half * 2048; }
__device__ __forceinline__ int crow(int r, int hi) { return (r & 3) + 8 * (r >> 2) + 4 * hi; }
__device__ __forceinline__ unsigned cvtpk(float lo, float hi) {
    unsigned r; asm volatile("v_cvt_pk_bf16_f32 %0, %1, %2" : "=v"(r) : "v"(lo), "v"(hi)); return r;
}
__device__ __forceinline__ bf16x8 pack8(f32x4 a, f32x4 b) {
    u32x4 w = {cvtpk(a[0], a[1]), cvtpk(a[2], a[3]), cvtpk(b[0], b[1]), cvtpk(b[2], b[3])};
    return *reinterpret_cast<bf16x8*>(&w);
}
template <class T> __device__ __forceinline__ bf16x8 load8(const T* p) {
    if constexpr (same_t<T, float>::v) { return pack8(*(const f32x4*)p, *(const f32x4*)(p + 4)); }
    else { return *reinterpret_cast<const bf16x8*>(p); }
}
__device__ __forceinline__ void mask_tile(f32x16& p0, f32x16& p1, int dq, unsigned W) {
    const float NEG = -__builtin_inff();
#pragma unroll
    for (int r = 0; r < 16; ++r) {
        const int c = (r & 3) + 8 * (r >> 2);
        if ((unsigned)(dq - c) >= W) p0[r] = NEG;
        if ((unsigned)(dq - c - 32) >= W) p1[r] = NEG;
    }
}
__device__ __forceinline__ void partialSM(f32x16& p0, f32x16& p1, float& m_reg, float& mn, float& alpha) {
    float pmax = p0[0]; for (int r = 1; r < 16; ++r) pmax = fmaxf(pmax, p0[r]); for (int r = 0; r < 16; ++r) pmax = fmaxf(pmax, p1[r]);
    { auto rr = __builtin_amdgcn_permlane32_swap(__float_as_uint(pmax), __float_as_uint(pmax), false, false);
      pmax = fmaxf(__uint_as_float(rr[0]), __uint_as_float(rr[1])); }
    constexpr float C2 = 1.4426950408889634f * SCALE;
    if (__builtin_expect(__all((pmax - m_reg) * SCALE <= THR), 1)) { mn = m_reg; alpha = 1.f; }
    else { mn = fmaxf(m_reg, pmax); alpha = __builtin_amdgcn_exp2f((m_reg - mn) * C2); m_reg = mn; }
    const float mnL = -mn * C2;
    for (int r = 0; r < 16; ++r) p0[r] = fmaf(p0[r], C2, mnL); for (int r = 0; r < 16; ++r) p1[r] = fmaf(p1[r], C2, mnL);
    for (int r = 0; r < 16; ++r) p0[r] = __builtin_amdgcn_exp2f(p0[r]);
}
__device__ __forceinline__ void finishSM(f32x16& p0, f32x16& p1, float alpha, float& l_reg, bf16x8& pa0, bf16x8& pa1, bf16x8& pa2, bf16x8& pa3) {
    for (int r = 0; r < 16; ++r) p1[r] = __builtin_amdgcn_exp2f(p1[r]);
    float ps = 0; for (int r = 0; r < 16; ++r) ps += p0[r]; for (int r = 0; r < 16; ++r) ps += p1[r];
    { auto rr = __builtin_amdgcn_permlane32_swap(__float_as_uint(ps), __float_as_uint(ps), false, false);
      ps = __uint_as_float(rr[0]) + __uint_as_float(rr[1]); }
    l_reg = l_reg * alpha + ps;
#define PK4(P, B_, OUT) do { unsigned a0 = cvtpk(P[B_+0], P[B_+1]), a1 = cvtpk(P[B_+2], P[B_+3]);                          \
        unsigned b0 = cvtpk(P[B_+4], P[B_+5]), b1 = cvtpk(P[B_+6], P[B_+7]);                                             \
        auto r0 = __builtin_amdgcn_permlane32_swap(a0, b0, false, false); auto r1 = __builtin_amdgcn_permlane32_swap(a1, b1, false, false); \
        u32x4 w = {r0[0], r1[0], r0[1], r1[1]}; OUT = *reinterpret_cast<bf16x8*>(&w); } while (0)
    PK4(p0, 0, pa0); PK4(p0, 8, pa1); PK4(p1, 0, pa2); PK4(p1, 8, pa3);
#undef PK4
}
template <int KB, bool SK>
__device__ __forceinline__ void qkt(f32x16& p0, f32x16& p1, const char* K_lds, int r32, int hi, const bf16x8* qr, bool act) {
    if (SK && !act) { const float NEG = -__builtin_inff();
#pragma unroll
        for (int r = 0; r < 16; ++r) { p0[r] = NEG; p1[r] = NEG; } return; }
    p0 = f32x16{}; p1 = f32x16{};
    const char* kb[4];
#pragma unroll
    for (int dd = 0; dd < 4; ++dd) kb[dd] = K_lds + KB * SHM_K + KSWZ(r32, (dd * 16 + hi * 8) * 2);
#pragma unroll
    for (int d0 = 0; d0 < 8; ++d0) { const char* a = kb[d0 & 3] + (d0 >> 2) * 128;
        bf16x8 b0 = *reinterpret_cast<const bf16x8*>(a);
        bf16x8 b1 = *reinterpret_cast<const bf16x8*>(a + 32 * 256);
        p0 = __builtin_amdgcn_mfma_f32_32x32x16_bf16(b0, qr[d0], p0, 0, 0, 0);
        p1 = __builtin_amdgcn_mfma_f32_32x32x16_bf16(b1, qr[d0], p1, 0, 0, 0); }
}
template <int VB, bool SK>
__device__ __forceinline__ void pv_tile(f32x16* o, int vb0, bf16x8 pa0, bf16x8 pa1, bf16x8 pa2, bf16x8 pa3, bool act) {
    if (SK && !act) return;
#define TRRD(dst, off) asm volatile("ds_read_b64_tr_b16 %0, %1 offset:%2" : "=&v"(dst) : "v"(vb0), "i"(off) : "memory")
#define PV_D0(d0) do { s16x4 l0, l1, l2, l3, h0, h1, h2, h3; constexpr int b_ = VB * SHM_V + v_rd_off(d0, 0, 0);     \
        TRRD(l0, b_); TRRD(h0, b_ + 2048); TRRD(l1, b_ + 4096); TRRD(h1, b_ + 6144); TRRD(l2, b_ + 8192); TRRD(h2, b_ + 10240); TRRD(l3, b_ + 12288); TRRD(h3, b_ + 14336); \
        asm volatile("s_waitcnt lgkmcnt(0)" ::: "memory"); SBAR();                 \
        o[d0] = __builtin_amdgcn_mfma_f32_32x32x16_bf16(pa0, (bf16x8){l0[0], l0[1], l0[2], l0[3], h0[0], h0[1], h0[2], h0[3]}, o[d0], 0, 0, 0);   \
        o[d0] = __builtin_amdgcn_mfma_f32_32x32x16_bf16(pa1, (bf16x8){l1[0], l1[1], l1[2], l1[3], h1[0], h1[1], h1[2], h1[3]}, o[d0], 0, 0, 0);   \
        o[d0] = __builtin_amdgcn_mfma_f32_32x32x16_bf16(pa2, (bf16x8){l2[0], l2[1], l2[2], l2[3], h2[0], h2[1], h2[2], h2[3]}, o[d0], 0, 0, 0);   \
        o[d0] = __builtin_amdgcn_mfma_f32_32x32x16_bf16(pa3, (bf16x8){l3[0], l3[1], l3[2], l3[3], h3[0], h3[1], h3[2], h3[3]}, o[d0], 0, 0, 0); } while (0)
    PV_D0(0); PV_D0(1); PV_D0(2); PV_D0(3);
#undef PV_D0
#undef TRRD
}

template <class TIn, class TOut> struct BlockRef { const TIn* Q; const TIn* K; const TIn* V; TOut* O; int P0; };
template <class TIn> struct Seam {
    bf16x8 qr[8];
    bf16x8 st_v0, st_v1, st_k0, st_k1; f32x4 sf0, sf1, sf2, sf3;
    f32x4 tq[16];
};
__device__ __forceinline__ int swa_jlo(int P0, int W) { const int lowk = P0 - W + 1; return lowk > 0 ? lowk / KVBLK : 0; }
#define ROW(p, k0, rr) ((p) + (size_t)((k0) + (rr)) * D + sc)
#define VMW() asm volatile("s_waitcnt vmcnt(0)" ::: "memory")
#define VMWN(n) asm volatile("s_waitcnt vmcnt(%0)" :: "i"(n) : "memory")
#define SLOAD_H(Kp, Vp, k0) do { S.st_v0 = load8<TIn>(ROW(Vp, k0, sr)); S.st_v1 = load8<TIn>(ROW(Vp, k0, 32 + sr));              \
                         S.st_k0 = load8<TIn>(ROW(Kp, k0, sr)); S.st_k1 = load8<TIn>(ROW(Kp, k0, 32 + sr)); } while (0)
#define SWRITE_HK(bf) do { *(bf16x8*)(K_lds + (bf) * SHM_K + kws) = S.st_k0; *(bf16x8*)(K_lds + (bf) * SHM_K + kws + 32 * 256) = S.st_k1; } while (0)
#define SWRITE_HV(bf) do { *(bf16x8*)(V_lds + (bf) * SHM_V + vst0) = S.st_v0; *(bf16x8*)(V_lds + (bf) * SHM_V + vst1) = S.st_v1; } while (0)
#define SWRITE_H(bf) do { SWRITE_HV(bf); SWRITE_HK(bf); } while (0)
#define SLOAD_F(p, k0) do { S.sf0 = *(const f32x4*)ROW(p, k0, sr); S.sf1 = *(const f32x4*)(ROW(p, k0, sr) + 4);                \
                            S.sf2 = *(const f32x4*)ROW(p, k0, 32 + sr); S.sf3 = *(const f32x4*)(ROW(p, k0, 32 + sr) + 4); } while (0)
#define SWRITE_KF(bf) do { *(bf16x8*)(K_lds + (bf) * SHM_K + kws) = pack8(S.sf0, S.sf1); *(bf16x8*)(K_lds + (bf) * SHM_K + kws + 32 * 256) = pack8(S.sf2, S.sf3); } while (0)
#define SWRITE_VF(bf) do { *(bf16x8*)(V_lds + (bf) * SHM_V + vst0) = pack8(S.sf0, S.sf1); *(bf16x8*)(V_lds + (bf) * SHM_V + vst1) = pack8(S.sf2, S.sf3); } while (0)
template <class TIn, class TOut>
__device__ __forceinline__ void causal_swa_prime(const BlockRef<TIn, TOut>& cur, int W, char* lds, Seam<TIn>& S) {
    constexpr bool F32 = same_t<TIn, float>::v;
    const int tid = threadIdx.x, wid = __builtin_amdgcn_readfirstlane(tid >> 6), lane = tid & 63, r32 = lane & 31, hi = lane >> 5;
    const int sr = tid >> 4, sc = (tid & 15) * 8, kws = KSWZ(sr, sc * 2); char* K_lds = lds + 2 * SHM_V;
    const int kb0 = swa_jlo(cur.P0, W) * KVBLK;
    for (int d0 = 0; d0 < 8; ++d0) S.qr[d0] = load8<TIn>(cur.Q + (size_t)(wid * QBLK + r32) * D + d0 * 16 + hi * 8);
    if constexpr (F32) { SLOAD_F((const float*)cur.K, kb0); VMW(); SWRITE_KF(0); SBAR(); SLOAD_F((const float*)cur.V, kb0); }
    else { SLOAD_H(cur.K, cur.V, kb0); VMW(); SWRITE_HK(0); }
    __syncthreads();
}
template <class TIn, class TOut>
__device__ __forceinline__ void causal_swa_block(const BlockRef<TIn, TOut>& cur, const BlockRef<TIn, TOut>& nxt, int skv, int W, char* lds, Seam<TIn>& S) {
    constexpr bool F32 = same_t<TIn, float>::v;
    const int tid = threadIdx.x, wid = __builtin_amdgcn_readfirstlane(tid >> 6), lane = tid & 63, r32 = lane & 31, hi = lane >> 5;
    const int j_lo = swa_jlo(cur.P0, W);
    int j_hi = (cur.P0 + QB - 1) / KVBLK + 1; if (j_hi > skv / KVBLK) j_hi = skv / KVBLK;
    const int NT = j_hi - j_lo;
    const int kbn = swa_jlo(nxt.P0, W) * KVBLK;
    const int qlo = cur.P0 + wid * QBLK, qm = qlo + r32 - 4 * hi;
    char* V_lds = lds; char* K_lds = lds + 2 * SHM_V;
    float* ws = (float*)(lds + 2 * SHM_V + 2 * SHM_K) + wid * 64; float* li_l = ws, * al_l = ws + 32;
    float m_reg = -1e30f, l_reg = 0; f32x16 o[4] = {};
    const int sr = tid >> 4, sc = (tid & 15) * 8, vst0 = v_st(sr, sc), vst1 = v_st(32 + sr, sc), kws = KSWZ(sr, sc * 2);
    const int vb0 = (int)(uintptr_t)V_lds + v_rd_base(lane);
    const TIn* Kh = cur.K; const TIn* Vh = cur.V;
#define RESC(a) do { if (__any((a) < 1.f)) { if (hi == 0) al_l[r32] = (a); asm volatile("s_waitcnt lgkmcnt(0)" ::: "memory");              \
                     for (int d_ = 0; d_ < 4; ++d_) for (int r = 0; r < 16; ++r) o[d_][r] *= al_l[crow(r, hi)]; } } while (0)
#define KBASE(t) ((j_lo + (t)) * KVBLK)
#define ACT(t) (KBASE(t) <= qlo + QBLK - 1 && KBASE(t) + KVBLK - 1 >= qlo - W + 1)
#define MASKT(P0_, P1_, t) do { const int kb_ = KBASE(t); if ((!SK || ACT(t)) && (kb_ + KVBLK - 1 > qlo || kb_ <= qlo + QBLK - 1 - W)) mask_tile(P0_, P1_, qm - kb_, (unsigned)W); } while (0)
    constexpr int NQL = F32 ? 16 : 8;
    constexpr bool SK = WSKIP && !F32;
#define SEAM_K0() do { VMWN(NQL); if constexpr (F32) { SWRITE_KF(0); SBAR(); SLOAD_F((const float*)nxt.V, kbn); } else { SWRITE_HK(0); } SBAR(); } while (0)
    f32x16 pA0, pA1, pB0, pB1; float mnA, mnB, alA, alB; bf16x8 pa0, pa1, pa2, pa3;
    if constexpr (F32) { VMW(); SWRITE_VF(0); SBAR(); } else { SWRITE_HV(0); SBAR(); }
    if (NT > 1) { if constexpr (F32) SLOAD_F((const float*)Kh, KBASE(1)); else SLOAD_H(Kh, Vh, KBASE(1)); }
    SBAR(); qkt<0, SK>(pA0, pA1, K_lds, r32, hi, S.qr, ACT(0));
    if constexpr (F32) { if (NT > 1) { VMW(); SWRITE_KF(1); SBAR(); SLOAD_F((const float*)Vh, KBASE(1)); } }
    MASKT(pA0, pA1, 0); partialSM(pA0, pA1, m_reg, mnA, alA);
    if (NT > 1) { VMW(); if constexpr (F32) { SWRITE_VF(1); SBAR(); if (NT > 2) SLOAD_F((const float*)Kh, KBASE(2)); } else SWRITE_H(1); }
    __syncthreads();
#define HALF_STEP(PX0, PX1, mnX, alX, PY0, PY1, alY, t, KB, VB, SB) do {                                                      \
        SBAR(); qkt<KB, SK>(PX0, PX1, K_lds, r32, hi, S.qr, ACT(t));                                             \
        finishSM(PY0, PY1, alY, l_reg, pa0, pa1, pa2, pa3); SBAR();                                                           \
        if ((t) + 1 < NT) { if constexpr (F32) { VMW(); SWRITE_KF(SB); SBAR(); SLOAD_F((const float*)Vh, KBASE((t) + 1)); }  \
                            else { SLOAD_H(Kh, Vh, KBASE((t) + 1)); } SBAR(); }                                               \
        pv_tile<VB, SK>(o, vb0, pa0, pa1, pa2, pa3, ACT((t) - 1)); MASKT(PX0, PX1, (t)); partialSM(PX0, PX1, m_reg, mnX, alX);                                        \
        __syncthreads();                                                                                                      \
        if ((t) + 1 < NT) { VMW(); if constexpr (F32) { SWRITE_VF(SB); SBAR(); if ((t) + 2 < NT) SLOAD_F((const float*)Kh, KBASE((t) + 2)); } \
                            else { SWRITE_H(SB); } }                                                                          \
        RESC(alX); __syncthreads(); } while (0)
    for (int t = 1; t + 1 < NT; t += 2) {
        HALF_STEP(pB0, pB1, mnB, alB, pA0, pA1, alA, t, 1, 0, 0);
        HALF_STEP(pA0, pA1, mnA, alA, pB0, pB1, alB, t + 1, 0, 1, 1);
    }
    const bool even = (NT & 1) == 0;
    if (even) { SBAR(); qkt<1, SK>(pB0, pB1, K_lds, r32, hi, S.qr, ACT(NT - 1)); SBAR(); }
#define QROW(e) (nxt.Q + (size_t)(wid * QBLK + r32) * D + ((e) >> 1) * 16 + hi * 8 + ((e) & 1) * 4)
    if constexpr (F32) { SLOAD_F((const float*)nxt.K, kbn); SBAR();
#pragma unroll
        for (int e = 0; e < 8; ++e) S.tq[e] = *(const f32x4*)QROW(e); }
    else { SLOAD_H(nxt.K, nxt.V, kbn); SBAR();
#pragma unroll
        for (int d0 = 0; d0 < 8; ++d0) S.qr[d0] = load8<TIn>(nxt.Q + (size_t)(wid * QBLK + r32) * D + d0 * 16 + hi * 8); }
    SBAR();
    finishSM(pA0, pA1, alA, l_reg, pa0, pa1, pa2, pa3); SBAR();
    if constexpr (F32) {
#pragma unroll
        for (int e = 8; e < 16; ++e) S.tq[e] = *(const f32x4*)QROW(e); SBAR(); }
#undef QROW
    pv_tile<0, SK>(o, vb0, pa0, pa1, pa2, pa3, ACT(even ? NT - 2 : NT - 1));
    if (even) { MASKT(pB0, pB1, NT - 1); partialSM(pB0, pB1, m_reg, mnB, alB); __syncthreads(); RESC(alB);
        finishSM(pB0, pB1, alB, l_reg, pa0, pa1, pa2, pa3); SBAR(); pv_tile<1, SK>(o, vb0, pa0, pa1, pa2, pa3, ACT(NT - 1)); }
    SBAR(); SEAM_K0();
    if (hi == 0) li_l[r32] = l_reg; asm volatile("s_waitcnt lgkmcnt(0)" ::: "memory");
    float rli[16];
#pragma unroll
    for (int r = 0; r < 16; ++r) rli[r] = __builtin_amdgcn_rcpf(li_l[crow(r, hi)]);
    TOut* Ow = cur.O + (size_t)(wid * QBLK) * D;
#pragma unroll
    for (int r = 0; r < 16; ++r) { const int orow = crow(r, hi);
#pragma unroll
        for (int d0 = 0; d0 < 4; ++d0) { const float v = o[d0][r] * rli[r];
            if constexpr (same_t<TOut, float>::v) { Ow[(size_t)orow * D + d0 * 32 + r32] = v; }
            else { const float vn = __shfl_xor(v, 1);
                   if ((r32 & 1) == 0) *(unsigned*)(Ow + (size_t)orow * D + d0 * 32 + r32) = cvtpk(v, vn); } } }
    if constexpr (F32) {
#pragma unroll
        for (int d0 = 0; d0 < 8; ++d0) S.qr[d0] = pack8(S.tq[2 * d0], S.tq[2 * d0 + 1]); }
    __syncthreads();
#undef RESC
#undef KBASE
#undef ACT
#undef MASKT
#undef SEAM_K0
#undef HALF_STEP
}
#undef ROW
#undef VMW
#undef VMWN
#undef SLOAD_H
#undef SWRITE_HK
#undef SWRITE_HV
#undef SWRITE_H
#undef SLOAD_F
#undef SWRITE_KF
#undef SWRITE_VF

template <int VB0>
__device__ __forceinline__ void pv8(f32x16* o, int vb0, bf16x8 pa0, bf16x8 pa1, bf16x8 pa2, bf16x8 pa3) {
    s16x4 l0, h0, l1, h1, l2, h2, l3, h3;
#define TRRD(dst, off) asm volatile("ds_read_b64_tr_b16 %0, %1 offset:%2" : "=&v"(dst) : "v"(vb0), "i"(off) : "memory")
#define PV8_OFF(d0) ((VB0 + ((d0) >> 2)) * SHM_V + v_rd_off((d0) & 3, 0, 0))
#define PV8_RX(d0) do { TRRD(l0, PV8_OFF(d0)); TRRD(h0, PV8_OFF(d0) + 2048); TRRD(l1, PV8_OFF(d0) + 4096); TRRD(h1, PV8_OFF(d0) + 6144); } while (0)
#define PV8_RY(d0) do { TRRD(l2, PV8_OFF(d0) + 8192); TRRD(h2, PV8_OFF(d0) + 10240); TRRD(l3, PV8_OFF(d0) + 12288); TRRD(h3, PV8_OFF(d0) + 14336); } while (0)
#define PV8_STEP(d0, LAST) do { \
        asm volatile("s_waitcnt lgkmcnt(4)" ::: "memory"); SBAR(); \
        o[d0] = __builtin_amdgcn_mfma_f32_32x32x16_bf16(pa0, (bf16x8){l0[0], l0[1], l0[2], l0[3], h0[0], h0[1], h0[2], h0[3]}, o[d0], 0, 0, 0); \
        o[d0] = __builtin_amdgcn_mfma_f32_32x32x16_bf16(pa1, (bf16x8){l1[0], l1[1], l1[2], l1[3], h1[0], h1[1], h1[2], h1[3]}, o[d0], 0, 0, 0); SBAR(); \
        if (!(LAST)) { PV8_RX((d0) + 1); asm volatile("s_waitcnt lgkmcnt(4)" ::: "memory"); } else { asm volatile("s_waitcnt lgkmcnt(0)" ::: "memory"); } SBAR(); \
        o[d0] = __builtin_amdgcn_mfma_f32_32x32x16_bf16(pa2, (bf16x8){l2[0], l2[1], l2[2], l2[3], h2[0], h2[1], h2[2], h2[3]}, o[d0], 0, 0, 0); \
        o[d0] = __builtin_amdgcn_mfma_f32_32x32x16_bf16(pa3, (bf16x8){l3[0], l3[1], l3[2], l3[3], h3[0], h3[1], h3[2], h3[3]}, o[d0], 0, 0, 0); SBAR(); \
        if (!(LAST)) PV8_RY((d0) + 1); } while (0)
    PV8_RX(0); PV8_RY(0);
    PV8_STEP(0, false); PV8_STEP(1, false); PV8_STEP(2, false); PV8_STEP(3, false); PV8_STEP(4, false); PV8_STEP(5, false); PV8_STEP(6, false); PV8_STEP(7, true);
#undef PV8_STEP
#undef PV8_RY
#undef PV8_RX
#undef PV8_OFF
#undef TRRD
}
struct Ref2 { const unsigned short* Q; const unsigned short* K; const unsigned short* V0; const unsigned short* V1; float* X; unsigned short* RA; float lam; int P0; };
constexpr int A2_LDS = 4 * SHM_V + 2 * SHM_K + NW * 64 * 4;
template <int MODE  >
__device__ __forceinline__ void attn2_block(const Ref2& cur, char* lds, int wave_id) {
    typedef unsigned short T;
    constexpr int W = 1 << 20;
    const int lane = mk_lane(), wid = wave_id, r32 = lane & 31, hi = lane >> 5;
    const int NT = (cur.P0 + QB) / KVBLK;
    const int qlo = cur.P0 + wid * QBLK, qm = qlo + r32 - 4 * hi;
    char* V_lds = lds; char* K_lds = lds + 4 * SHM_V;
    float* ws = (float*)(lds + 4 * SHM_V + 2 * SHM_K) + wid * 64; float* li_l = ws; float* al_l = ws + 32;
    const int vb0 = (int)(uintptr_t)V_lds + v_rd_base(lane);
    bf16x8 qr[8];
#pragma unroll
    for (int d0 = 0; d0 < 8; ++d0) qr[d0] = load8<T>(cur.Q + (size_t)(wid * QBLK + r32) * D + d0 * 16 + hi * 8);
    const unsigned krow = 4 * wid + (lane >> 4), kgo = krow * 256 + (((lane & 15) * 16) ^ ((krow & 7) << 4));
    const unsigned vkk = 8 * (wid >> 1) + ((lane & 31) >> 2), vk = (vkk & ~0xCu) | ((vkk & 4) << 1) | ((vkk & 8) >> 1), vgo = vk * 256 + (32 * (2 * (wid & 1) + (lane >> 5)) + 8 * (lane & 3)) * 2;
    typedef __attribute__((address_space(3))) unsigned lds_u32;
#define A2_DMA(k0, bf) do { const char* kp_ = (const char*)cur.K + (size_t)(k0) * 256; const char* v0_ = (const char*)cur.V0 + (size_t)(k0) * 256; const char* v1_ = (const char*)cur.V1 + (size_t)(k0) * 256; \
        char* kl_ = K_lds + (bf) * SHM_K + wid * 1024; char* vl_ = V_lds + (2 * (bf)) * SHM_V + wid * 1024; \
        __builtin_amdgcn_global_load_lds((const unsigned*)(kp_ + kgo), (lds_u32*)kl_, 16, 0, 0); __builtin_amdgcn_global_load_lds((const unsigned*)(kp_ + 8192 + kgo), (lds_u32*)(kl_ + 8192), 16, 0, 0); \
        __builtin_amdgcn_global_load_lds((const unsigned*)(v0_ + vgo), (lds_u32*)vl_, 16, 0, 0); __builtin_amdgcn_global_load_lds((const unsigned*)(v0_ + 8192 + vgo), (lds_u32*)(vl_ + 8192), 16, 0, 0); \
        __builtin_amdgcn_global_load_lds((const unsigned*)(v1_ + vgo), (lds_u32*)(vl_ + SHM_V), 16, 0, 0); __builtin_amdgcn_global_load_lds((const unsigned*)(v1_ + 8192 + vgo), (lds_u32*)(vl_ + SHM_V + 8192), 16, 0, 0); } while (0)
    A2_DMA(0, 0);
    asm volatile("s_waitcnt vmcnt(0)" ::: "memory"); __syncthreads();
    float m_reg = -1e30f, l_reg = 0.f; f32x16 o[8] = {};
#define A2_STEP(t, BF) do { \
        f32x16 p0, p1; SBAR(); qkt<BF, false>(p0, p1, K_lds, r32, hi, qr, true); SBAR(); \
        if ((t) + 1 < NT) A2_DMA(((t) + 1) * KVBLK, 1 - BF);     \
        SBAR(); \
        { const int kb_ = (t) * KVBLK; if (kb_ + KVBLK - 1 > qlo) mask_tile(p0, p1, qm - kb_, (unsigned)W); } \
        float mn, al; partialSM(p0, p1, m_reg, mn, al); bf16x8 pa0, pa1, pa2, pa3; finishSM(p0, p1, al, l_reg, pa0, pa1, pa2, pa3); SBAR(); \
        if (__any(al < 1.f)) { if (hi == 0) al_l[r32] = al; asm volatile("s_waitcnt lgkmcnt(0)" ::: "memory"); \
            _Pragma("unroll") for (int r = 0; r < 16; ++r) { const float a_ = al_l[crow(r, hi)]; _Pragma("unroll") for (int d_ = 0; d_ < 8; ++d_) o[d_][r] *= a_; } } \
        pv8<2 * BF>(o, vb0, pa0, pa1, pa2, pa3); \
        asm volatile("s_waitcnt vmcnt(0)" ::: "memory"); __syncthreads(); } while (0)
    for (int t = 0; t < NT; t += 2) { A2_STEP(t, 0); A2_STEP(t + 1, 1); }
#undef A2_STEP
#undef A2_DMA
    int r32e = r32, hie = hi, le = lane; asm volatile("" : "+v"(r32e), "+v"(hie), "+v"(le));
    if (hie == 0) li_l[r32e] = l_reg; asm volatile("s_waitcnt lgkmcnt(0)" ::: "memory");
#pragma unroll
    for (int r = 0; r < 16; ++r) { const float rl = __builtin_amdgcn_rcpf(li_l[crow(r, hie)]);
#pragma unroll
        for (int d0 = 0; d0 < 8; ++d0) o[d0][r] *= rl; }
    u32x4* Xw = (u32x4*)cur.X + (size_t)wid * (16 * 64) + le;
    if (MODE == 0) {
#pragma unroll
        for (int d0 = 0; d0 < 8; ++d0)
#pragma unroll
            for (int r8 = 0; r8 < 2; ++r8) { u32x4 w; w.x = cvtpk(o[d0][8 * r8], o[d0][8 * r8 + 1]); w.y = cvtpk(o[d0][8 * r8 + 2], o[d0][8 * r8 + 3]); w.z = cvtpk(o[d0][8 * r8 + 4], o[d0][8 * r8 + 5]); w.w = cvtpk(o[d0][8 * r8 + 6], o[d0][8 * r8 + 7]);
                Xw[(2 * d0 + r8) * 64] = w; }
    } else {
        const float lam = cur.lam;
#pragma unroll
        for (int d0 = 0; d0 < 8; ++d0)
#pragma unroll
            for (int r8 = 0; r8 < 2; ++r8) { const u32x4 a = Xw[(2 * d0 + r8) * 64];
#pragma unroll
                for (int e = 0; e < 4; ++e) { const unsigned w = a[e]; const int r0 = 8 * r8 + 2 * e;
                    o[d0][r0] = __builtin_bit_cast(float, w << 16) - lam * o[d0][r0]; o[d0][r0 + 1] = __builtin_bit_cast(float, w & 0xffff0000u) - lam * o[d0][r0 + 1]; } }
#pragma unroll
        for (int r = 0; r < 16; ++r) { float ss = 0.f;
#pragma unroll
            for (int d0 = 0; d0 < 8; ++d0) ss += o[d0][r] * o[d0][r];
            ss += __shfl_xor(ss, 1); ss += __shfl_xor(ss, 2); ss += __shfl_xor(ss, 4); ss += __shfl_xor(ss, 8); ss += __shfl_xor(ss, 16);
            const float rs_ = __builtin_amdgcn_rsqf(ss * (1.0f / 256.0f) + 1e-5f);
#pragma unroll
            for (int d0 = 0; d0 < 8; ++d0) o[d0][r] *= rs_; }
        char* stg = lds + wid * (32 * 136 * 2);
#pragma unroll
        for (int hf = 0; hf < 2; ++hf) {
#pragma unroll
            for (int r = 0; r < 16; ++r)
#pragma unroll
                for (int d4 = 0; d4 < 4; ++d4) { const float v = o[4 * hf + d4][r]; unsigned short b_; { unsigned u_ = __builtin_bit_cast(unsigned, v); b_ = (unsigned short)((u_ + 0x7fffu + ((u_ >> 16) & 1u)) >> 16); }
                    *(unsigned short*)(stg + (crow(r, hie) * 136 + d4 * 32 + r32e) * 2) = b_; }
            asm volatile("" ::: "memory");
#pragma unroll
            for (int j = 0; j < 8; ++j) { const int row = 4 * j + (le >> 4), ch = le & 15; const u32x4 w = *(const u32x4*)(stg + (row * 136 + ch * 8) * 2);
                *(u32x4*)(cur.RA + (size_t)(wid * QBLK + row) * 4096 + hf * 128 + ch * 8) = w; }
            asm volatile("" ::: "memory");
        }
        __syncthreads();
    }
}
constexpr int A16_V = 32768, A16_K = 16384, A16_KOFF = 2 * A16_V, A16_STAT = A16_KOFF + 2 * A16_K;
typedef __attribute__((address_space(3))) unsigned char a16_lds;
__device__ __forceinline__ bf16x8 a16_cat(s16x4 a, s16x4 b) { return (bf16x8){a[0], a[1], a[2], a[3], b[0], b[1], b[2], b[3]}; }
template <int MODE>
__device__ __forceinline__ void attn16_block(const Ref2& cur, char* lds_g, int wave_id) {
    typedef unsigned short T; typedef __attribute__((address_space(3))) unsigned lds_u32;
    const int lane = mk_lane(), wid = wave_id, fr = lane & 15, fq = lane >> 4, qq = (lane & 15) >> 2, pp = lane & 3;
    const int NT = (cur.P0 + QB) / KVBLK, qlo = cur.P0 + wid * QBLK;
    a16_lds* L = (a16_lds*)lds_g;
    __attribute__((address_space(3))) float* li_l = (__attribute__((address_space(3))) float*)(L + A16_STAT + wid * 256); __attribute__((address_space(3))) float* al_l = li_l + 32;
    bf16x8 qf[2][4];
#pragma unroll
    for (int qb = 0; qb < 2; ++qb)
#pragma unroll
        for (int ks = 0; ks < 4; ++ks) qf[qb][ks] = load8<T>(cur.Q + (size_t)(wid * QBLK + 16 * qb + fr) * D + 32 * ks + 8 * fq);
    const T* Vsrc = ((wid & 3) >> 1) ? cur.V1 : cur.V0;
#define A16_DMA(k0, bf) do { const int ld_ = mk_lane(); int kR, kC; pg8::stage_rc(wid * 1024 + ld_ * 16, kR, kC); const unsigned kgo = (unsigned)(kR * 128 + kC) * 2u; \
        const unsigned vgo = (unsigned)(8 * (wid >> 2) + ((ld_ >> 1) & 7)) * 256u + (unsigned)(16 * ((4 * (wid & 3) + (ld_ >> 4)) & 7) + 8 * (ld_ & 1)) * 2u; const char* kp_ = (const char*)cur.K + (size_t)(k0) * 256; const char* vp_ = (const char*)Vsrc + (size_t)(k0) * 256; \
        char* kl_ = lds_g + A16_KOFF + (bf) * A16_K + wid * 1024; char* vl_ = lds_g + (bf) * A16_V + wid * 1024; \
        __builtin_amdgcn_global_load_lds((const unsigned*)(kp_ + kgo), (lds_u32*)kl_, 16, 0, 0); __builtin_amdgcn_global_load_lds((const unsigned*)(kp_ + 128 + kgo), (lds_u32*)(kl_ + 8192), 16, 0, 0); \
        __builtin_amdgcn_global_load_lds((const unsigned*)(vp_ + vgo), (lds_u32*)vl_, 16, 0, 0); __builtin_amdgcn_global_load_lds((const unsigned*)(vp_ + 4096 + vgo), (lds_u32*)(vl_ + 8192), 16, 0, 0); \
        __builtin_amdgcn_global_load_lds((const unsigned*)(vp_ + 8192 + vgo), (lds_u32*)(vl_ + 16384), 16, 0, 0); __builtin_amdgcn_global_load_lds((const unsigned*)(vp_ + 12288 + vgo), (lds_u32*)(vl_ + 24576), 16, 0, 0); } while (0)
    A16_DMA(0, 0);
    asm volatile("s_waitcnt vmcnt(0)" ::: "memory"); __syncthreads();
    const int kbase = pg8::lds_byte(fr, 8 * fq);
    const int vbase = (fq >> 1) * 4096 + (4 * (fq & 1) + qq) * 32 + 8 * pp;
    float mref[2] = {0.f, 0.f}, l_reg[2] = {0.f, 0.f};
    f32x4 o[2][16];
#pragma unroll
    for (int qb = 0; qb < 2; ++qb)
#pragma unroll
        for (int vb = 0; vb < 16; ++vb) o[qb][vb] = (f32x4){0.f, 0.f, 0.f, 0.f};
    constexpr float PBIG = 1073741824.f;
#define A16_FADD(a_, b_) ((a_) + (b_))
#define A16_ROWRED(v_, OP) do { auto r16_ = __builtin_amdgcn_permlane16_swap(__float_as_uint(v_), __float_as_uint(v_), false, false); v_ = OP(__uint_as_float(r16_[0]), __uint_as_float(r16_[1])); \
        auto r32_ = __builtin_amdgcn_permlane32_swap(__float_as_uint(v_), __float_as_uint(v_), false, false); v_ = OP(__uint_as_float(r32_[0]), __uint_as_float(r32_[1])); } while (0)
    const int kaddr0 = (int)(unsigned)(uintptr_t)(L + A16_KOFF + kbase), vaddr0 = (int)(unsigned)(uintptr_t)(L + vbase);
#define A16_KRD(dst, off) asm volatile("ds_read_b128 %0, %1 offset:%2" : "=&v"(dst) : "v"(kaddr0), "i"(off) : "memory")
#define A16_VRD(dst, off) asm volatile("ds_read_b64_tr_b16 %0, %1 offset:%2" : "=&v"(dst) : "v"(vaddr0), "i"(off) : "memory")
#define A16_LW(n) do { asm volatile("s_waitcnt lgkmcnt(" #n ")" ::: "memory"); SBAR(); } while (0)
#define A16_KOFFS(BF, ks, kb) ((BF) * A16_K + ((ks) >> 1) * 8192 + (kb) * 2048 + ((ks) & 1) * 1024)
#define A16_KG(BF, g, x0, x1) do { A16_KRD(x0, A16_KOFFS(BF, (g) >> 1, 2 * ((g) & 1))); A16_KRD(x1, A16_KOFFS(BF, (g) >> 1, 2 * ((g) & 1) + 1)); } while (0)
#define A16_KM0(g, x0, x1) do { const f32x4 ctup[2] = {{mref[0], mref[0], mref[0], mref[0]}, {mref[1], mref[1], mref[1], mref[1]}};     \
        s[0][2 * ((g) & 1)] = __builtin_amdgcn_mfma_f32_16x16x32_bf16(x0, qf[0][(g) >> 1], ctup[0], 0, 0, 0); s[1][2 * ((g) & 1)] = __builtin_amdgcn_mfma_f32_16x16x32_bf16(x0, qf[1][(g) >> 1], ctup[1], 0, 0, 0); \
        s[0][2 * ((g) & 1) + 1] = __builtin_amdgcn_mfma_f32_16x16x32_bf16(x1, qf[0][(g) >> 1], ctup[0], 0, 0, 0); s[1][2 * ((g) & 1) + 1] = __builtin_amdgcn_mfma_f32_16x16x32_bf16(x1, qf[1][(g) >> 1], ctup[1], 0, 0, 0); } while (0)
#define A16_KM(g, x0, x1) do { \
        s[0][2 * ((g) & 1)] = __builtin_amdgcn_mfma_f32_16x16x32_bf16(x0, qf[0][(g) >> 1], s[0][2 * ((g) & 1)], 0, 0, 0); s[1][2 * ((g) & 1)] = __builtin_amdgcn_mfma_f32_16x16x32_bf16(x0, qf[1][(g) >> 1], s[1][2 * ((g) & 1)], 0, 0, 0); \
        s[0][2 * ((g) & 1) + 1] = __builtin_amdgcn_mfma_f32_16x16x32_bf16(x1, qf[0][(g) >> 1], s[0][2 * ((g) & 1) + 1], 0, 0, 0); s[1][2 * ((g) & 1) + 1] = __builtin_amdgcn_mfma_f32_16x16x32_bf16(x1, qf[1][(g) >> 1], s[1][2 * ((g) & 1) + 1], 0, 0, 0); } while (0)
#define A16_VOFFS(BF, i) ((BF) * A16_V + (4 * ((i) >> 4)) * 4096 + ((i) & 15) * 256)
#define A16_VG(BF, i, y0, y1) do { A16_VRD(y0, A16_VOFFS(BF, i)); A16_VRD(y1, A16_VOFFS(BF, i) + 2 * 4096); } while (0)
#define A16_VM(i, y0, y1) do { const bf16x8 vf_ = a16_cat(y0, y1); \
        o[0][(i) & 15] = __builtin_amdgcn_mfma_f32_16x16x32_bf16(pa[0][(i) >> 4], vf_, o[0][(i) & 15], 0, 0, 0); o[1][(i) & 15] = __builtin_amdgcn_mfma_f32_16x16x32_bf16(pa[1][(i) >> 4], vf_, o[1][(i) & 15], 0, 0, 0); } while (0)
#define A16_E1(i) do { s[(i) >> 3][((i) >> 2) & 1][(i) & 3] = __builtin_amdgcn_exp2f(s[(i) >> 3][((i) >> 2) & 1][(i) & 3]); ps[(i) >> 3] += s[(i) >> 3][((i) >> 2) & 1][(i) & 3]; } while (0)
#define A16_V2(BF, i) do {   \
        A16_VG(BF, (i) + 1, yb0, yb1); A16_LW(2); A16_VM(i, ya0, ya1); \
        if ((i) + 2 < 32) { A16_VG(BF, (i) + 2, ya0, ya1); A16_LW(2); } else A16_LW(0); A16_VM((i) + 1, yb0, yb1); } while (0)
#define A16_STEP(t, BF, FIRST) do { \
        if (__builtin_expect(!__all(l_reg[0] < PBIG && l_reg[1] < PBIG), 0)) {     \
            float al[2]; _Pragma("unroll") for (int qb = 0; qb < 2; ++qb) { float lm = l_reg[qb]; A16_ROWRED(lm, fmaxf); const float dl = lm > 1.f ? __builtin_amdgcn_logf(lm) : 0.f; al[qb] = __builtin_amdgcn_exp2f(-dl); l_reg[qb] *= al[qb]; mref[qb] -= dl; } \
            const int lr_ = mk_lane(), fr_ = lr_ & 15, fq_ = lr_ >> 4; if (fq_ == 0) { al_l[fr_] = al[0]; al_l[16 + fr_] = al[1]; } asm volatile("s_waitcnt lgkmcnt(0)" ::: "memory"); \
            _Pragma("unroll") for (int qb = 0; qb < 2; ++qb) _Pragma("unroll") for (int r = 0; r < 4; ++r) { const float a_ = al_l[16 * qb + 4 * fq_ + r]; _Pragma("unroll") for (int vb = 0; vb < 16; ++vb) o[qb][vb][r] *= a_; } } \
        f32x4 s[2][4]; bf16x8 xa0, xa1, xb0, xb1, xc0, xc1; float ps[2] = {0.f, 0.f};     \
        A16_KG(BF, 0, xa0, xa1); A16_KG(BF, 2, xb0, xb1); \
        A16_KG(BF, 4, xc0, xc1); A16_LW(4); A16_KM0(0, xa0, xa1); A16_KG(BF, 6, xa0, xa1); A16_LW(4); A16_KM(2, xb0, xb1); A16_KG(BF, 1, xb0, xb1); A16_LW(4); A16_KM(4, xc0, xc1); A16_KG(BF, 3, xc0, xc1); A16_LW(4); A16_KM(6, xa0, xa1);     \
        if ((t) * KVBLK + KVBLK - 1 > qlo) { const int lm_ = mk_lane(); _Pragma("unroll") for (int qb = 0; qb < 2; ++qb) { const int dq = qlo + 16 * qb + (lm_ & 15) - (t) * KVBLK - 4 * (lm_ >> 4); \
                _Pragma("unroll") for (int kb = 0; kb < 2; ++kb) _Pragma("unroll") for (int r = 0; r < 4; ++r) s[qb][kb][r] = (16 * kb + r > dq) ? -__builtin_inff() : s[qb][kb][r]; } } \
        A16_KG(BF, 5, xa0, xa1); A16_LW(4); A16_KM0(1, xb0, xb1); if (!(FIRST)) { A16_E1(0); A16_E1(1); A16_E1(2); A16_E1(3); }     \
        A16_KG(BF, 7, xb0, xb1); A16_LW(4); A16_KM(3, xc0, xc1); if (!(FIRST)) { A16_E1(4); A16_E1(5); A16_E1(6); A16_E1(7); }     \
        A16_LW(2); A16_KM(5, xa0, xa1); if (!(FIRST)) { A16_E1(8); A16_E1(9); A16_E1(10); A16_E1(11); }     \
        A16_LW(0); A16_KM(7, xb0, xb1); if (!(FIRST)) { A16_E1(12); A16_E1(13); A16_E1(14); A16_E1(15); }     \
        SBAR(); if ((t) + 1 < NT) A16_DMA(((t) + 1) * KVBLK, 1 - (BF)); SBAR(); \
        if ((t) * KVBLK + KVBLK - 1 > qlo) { const int lm_ = mk_lane(); _Pragma("unroll") for (int qb = 0; qb < 2; ++qb) { const int dq = qlo + 16 * qb + (lm_ & 15) - (t) * KVBLK - 4 * (lm_ >> 4); \
                _Pragma("unroll") for (int kb = 2; kb < 4; ++kb) _Pragma("unroll") for (int r = 0; r < 4; ++r) s[qb][kb][r] = (16 * kb + r > dq) ? -__builtin_inff() : s[qb][kb][r]; } } \
        if (FIRST) { _Pragma("unroll") for (int qb = 0; qb < 2; ++qb) {              \
                float pmax = s[qb][0][0]; _Pragma("unroll") for (int kb = 0; kb < 4; ++kb) _Pragma("unroll") for (int r = 0; r < 4; ++r) pmax = fmaxf(pmax, s[qb][kb][r]); \
                A16_ROWRED(pmax, fmaxf); \
                _Pragma("unroll") for (int kb = 0; kb < 4; ++kb) s[qb][kb] -= pmax; mref[qb] -= pmax; } \
            A16_E1(0); A16_E1(1); A16_E1(2); A16_E1(3); A16_E1(4); A16_E1(5); A16_E1(6); A16_E1(7); A16_E1(8); A16_E1(9); A16_E1(10); A16_E1(11); A16_E1(12); A16_E1(13); A16_E1(14); A16_E1(15); } \
        bf16x8 pa[2][2]; \
        _Pragma("unroll") for (int qb = 0; qb < 2; ++qb) { \
            _Pragma("unroll") for (int kb = 2; kb < 4; ++kb) _Pragma("unroll") for (int r = 0; r < 4; ++r) { s[qb][kb][r] = __builtin_amdgcn_exp2f(s[qb][kb][r]); ps[qb] += s[qb][kb][r]; } \
            l_reg[qb] += ps[qb];                                                    \
            _Pragma("unroll") for (int st = 0; st < 2; ++st) { u32x4 w = {cvtpk(s[qb][2 * st][0], s[qb][2 * st][1]), cvtpk(s[qb][2 * st][2], s[qb][2 * st][3]), cvtpk(s[qb][2 * st + 1][0], s[qb][2 * st + 1][1]), cvtpk(s[qb][2 * st + 1][2], s[qb][2 * st + 1][3])}; \
                pa[qb][st] = *reinterpret_cast<bf16x8*>(&w); } } \
        { s16x4 ya0, ya1, yb0, yb1, yc0, yc1; SBAR();     \
          A16_VG(BF, 0, ya0, ya1); A16_VG(BF, 1, yb0, yb1); \
          A16_VG(BF, 2, yc0, yc1); A16_LW(4); A16_VM(0, ya0, ya1); A16_VG(BF, 3, ya0, ya1); A16_LW(4); A16_VM(1, yb0, yb1); A16_VG(BF, 4, yb0, yb1); A16_LW(4); A16_VM(2, yc0, yc1); A16_VG(BF, 5, yc0, yc1); A16_LW(4); A16_VM(3, ya0, ya1); \
          A16_VG(BF, 6, ya0, ya1); A16_LW(4); A16_VM(4, yb0, yb1); A16_VG(BF, 7, yb0, yb1); A16_LW(4); A16_VM(5, yc0, yc1); A16_VG(BF, 8, yc0, yc1); A16_LW(4); A16_VM(6, ya0, ya1); A16_VG(BF, 9, ya0, ya1); A16_LW(4); A16_VM(7, yb0, yb1); \
          A16_VG(BF, 10, yb0, yb1); A16_LW(4); A16_VM(8, yc0, yc1); A16_VG(BF, 11, yc0, yc1); A16_LW(4); A16_VM(9, ya0, ya1); A16_VG(BF, 12, ya0, ya1); A16_LW(4); A16_VM(10, yb0, yb1); A16_VG(BF, 13, yb0, yb1); A16_LW(4); A16_VM(11, yc0, yc1); \
          A16_VG(BF, 14, yc0, yc1); A16_LW(4); A16_VM(12, ya0, ya1); A16_VG(BF, 15, ya0, ya1); A16_LW(4); A16_VM(13, yb0, yb1); A16_VG(BF, 16, yb0, yb1); A16_LW(4); A16_VM(14, yc0, yc1); A16_VG(BF, 17, yc0, yc1); A16_LW(4); A16_VM(15, ya0, ya1); \
          A16_VG(BF, 18, ya0, ya1); A16_LW(4); A16_VM(16, yb0, yb1); A16_VG(BF, 19, yb0, yb1); A16_LW(4); A16_VM(17, yc0, yc1); A16_VG(BF, 20, yc0, yc1); A16_LW(4); A16_VM(18, ya0, ya1); A16_VG(BF, 21, ya0, ya1); A16_LW(4); A16_VM(19, yb0, yb1); \
          A16_VG(BF, 22, yb0, yb1); A16_LW(4); A16_VM(20, yc0, yc1); A16_VG(BF, 23, yc0, yc1); A16_LW(4); A16_VM(21, ya0, ya1); A16_VG(BF, 24, ya0, ya1); A16_LW(4); A16_VM(22, yb0, yb1); A16_VG(BF, 25, yb0, yb1); A16_LW(4); A16_VM(23, yc0, yc1); \
          A16_VG(BF, 26, yc0, yc1); A16_LW(4); A16_VM(24, ya0, ya1); A16_VG(BF, 27, ya0, ya1); A16_LW(4); A16_VM(25, yb0, yb1); A16_VG(BF, 28, yb0, yb1); A16_LW(4); A16_VM(26, yc0, yc1); A16_VG(BF, 29, yc0, yc1); A16_LW(4); A16_VM(27, ya0, ya1); \
          A16_VG(BF, 30, ya0, ya1); A16_LW(4); A16_VM(28, yb0, yb1); A16_VG(BF, 31, yb0, yb1); A16_LW(4); A16_VM(29, yc0, yc1); A16_LW(2); A16_VM(30, ya0, ya1); A16_LW(0); A16_VM(31, yb0, yb1); } \
        asm volatile("s_waitcnt vmcnt(0)" ::: "memory"); __syncthreads(); } while (0)
    for (int t = 0; t < NT; t += 2) { A16_STEP(t, 0, (t) == 0); A16_STEP(t + 1, 1, false); }
#undef A16_STEP
#undef A16_V2
#undef A16_E1
#undef A16_VM
#undef A16_VG
#undef A16_VOFFS
#undef A16_KM
#undef A16_KM0
#undef A16_KG
#undef A16_KOFFS
#undef A16_LW
#undef A16_VRD
#undef A16_KRD
#undef A16_DMA
    const int le = mk_lane(), fre = le & 15, fqe = le >> 4;
    A16_ROWRED(l_reg[0], A16_FADD); A16_ROWRED(l_reg[1], A16_FADD);
    if (fqe == 0) { li_l[fre] = l_reg[0]; li_l[16 + fre] = l_reg[1]; } asm volatile("s_waitcnt lgkmcnt(0)" ::: "memory");
#pragma unroll
    for (int qb = 0; qb < 2; ++qb)
#pragma unroll
        for (int r = 0; r < 4; ++r) { const float rl = __builtin_amdgcn_rcpf(li_l[16 * qb + 4 * fqe + r]);
#pragma unroll
            for (int vb = 0; vb < 16; ++vb) o[qb][vb][r] *= rl; }
    u32x4* Xw = (u32x4*)cur.X + (size_t)wid * (16 * 64) + le;
    if (MODE == 0) {
#pragma unroll
        for (int qb = 0; qb < 2; ++qb)
#pragma unroll
            for (int v2 = 0; v2 < 8; ++v2) { u32x4 w = {cvtpk(o[qb][2 * v2][0], o[qb][2 * v2][1]), cvtpk(o[qb][2 * v2][2], o[qb][2 * v2][3]), cvtpk(o[qb][2 * v2 + 1][0], o[qb][2 * v2 + 1][1]), cvtpk(o[qb][2 * v2 + 1][2], o[qb][2 * v2 + 1][3])};
                Xw[(qb * 8 + v2) * 64] = w; }
    } else {
        const float lam = cur.lam;
#pragma unroll
        for (int qb = 0; qb < 2; ++qb)
#pragma unroll
            for (int v2 = 0; v2 < 8; ++v2) { const u32x4 a = Xw[(qb * 8 + v2) * 64];
#pragma unroll
                for (int e = 0; e < 4; ++e) { const unsigned w = a[e]; const int vb = 2 * v2 + (e >> 1), r0 = 2 * (e & 1);
                    o[qb][vb][r0] = __builtin_bit_cast(float, w << 16) - lam * o[qb][vb][r0]; o[qb][vb][r0 + 1] = __builtin_bit_cast(float, w & 0xffff0000u) - lam * o[qb][vb][r0 + 1]; } }
#pragma unroll
        for (int qb = 0; qb < 2; ++qb)
#pragma unroll
            for (int r = 0; r < 4; ++r) { float ss = 0.f;
#pragma unroll
                for (int vb = 0; vb < 16; ++vb) ss += o[qb][vb][r] * o[qb][vb][r];
#pragma unroll
                for (int k_ = 1; k_ < 16; k_ <<= 1) ss += __builtin_bit_cast(float, __builtin_amdgcn_ds_bpermute((le ^ k_) << 2, __builtin_bit_cast(int, ss)));
                const float rs_ = __builtin_amdgcn_rsqf(ss * (1.0f / 256.0f) + 1e-5f);
#pragma unroll
                for (int vb = 0; vb < 16; ++vb) o[qb][vb][r] *= rs_; }
        char* stg = lds_g + wid * (32 * 136 * 2);
#pragma unroll
        for (int hf = 0; hf < 2; ++hf) {
#pragma unroll
            for (int qb = 0; qb < 2; ++qb)
#pragma unroll
                for (int r = 0; r < 4; ++r)
#pragma unroll
                    for (int v8 = 0; v8 < 8; ++v8) { const float v = o[qb][8 * hf + v8][r]; unsigned u_ = __builtin_bit_cast(unsigned, v);
                        *(unsigned short*)(stg + ((16 * qb + 4 * fqe + r) * 136 + 16 * v8 + fre) * 2) = (unsigned short)((u_ + 0x7fffu + ((u_ >> 16) & 1u)) >> 16); }
            asm volatile("" ::: "memory");
#pragma unroll
            for (int j = 0; j < 8; ++j) { const int row = 4 * j + (le >> 4), ch = le & 15; const u32x4 w = *(const u32x4*)(stg + (row * 136 + ch * 8) * 2);
                *(u32x4*)(cur.RA + (size_t)(wid * QBLK + row) * 4096 + hf * 128 + ch * 8) = w; }
            asm volatile("" ::: "memory");
        }
        __syncthreads();
    }
}
#undef A16_ROWRED
#undef A16_FADD
}
constexpr int NWAVES = 8;
#ifndef MK_N_LAUNCHES
#define MK_N_LAUNCHES 1
#endif
constexpr int NPH = 17;
#ifndef MK_SP2
#define MK_SP2 true
#endif
#ifndef MK_ALIGN
#define MK_ALIGN true
#endif
#ifndef MK_EXTRA_BARRIERS
#define MK_EXTRA_BARRIERS 0
#endif
#ifndef MK_REPEAT_BARRIER
#define MK_REPEAT_BARRIER 0
#endif
#ifndef MK_NSTAT
#define MK_NSTAT 0
#endif
#ifndef MK_PROBE_COLDW
#define MK_PROBE_COLDW 0
#endif
#ifndef MK_FFN_SPLIT
#define MK_FFN_SPLIT 1
#endif
#ifndef MK_KVQ_SPLIT
#define MK_KVQ_SPLIT 0
#endif
#ifndef MK_REPEAT_MASK
#define MK_REPEAT_MASK 0
#endif
#ifndef MK_PHASE_MASK
#define MK_PHASE_MASK 0x1ffff
#endif
constexpr int N_LAUNCHES = MK_N_LAUNCHES;
constexpr int BATCH = 2, T = 8192, D = 4096, M = BATCH * T, FF = 11008;
constexpr size_t MiB = 1u << 20;
constexpr size_t WS_CTL = 0, CTL_ZERO_BYTES = 1 * MiB;
constexpr size_t WS_COS = 1 * MiB, WS_SIN = 5 * MiB, WS_PS = 9 * MiB, WS_RS = 13 * MiB;
constexpr size_t WS_WIN = 16 * MiB, WS_WRO = 144 * MiB, WS_WKVQ = 176 * MiB, WS_WDO = 272 * MiB, WS_WGU = 304 * MiB, WS_WDN = 648 * MiB;
constexpr size_t WS_XN = 820 * MiB, WS_RA = 948 * MiB, WS_Y = 1076 * MiB, WS_A = 1204 * MiB, WS_B = 1716 * MiB, WS_END = 2228 * MiB;
constexpr size_t WGU_BYTES = (size_t)2 * FF * D * 2, WDN_BYTES = (size_t)D * FF * 2;
constexpr int CW_BAR = 4096;
constexpr int LDS_BYTES = 147456, MISC_OFF = 139264;

#define GAS __attribute__((address_space(1)))
#define LAS __attribute__((address_space(3)))
typedef unsigned short bf16;
typedef unsigned v4u __attribute__((ext_vector_type(4)));
typedef unsigned v2u __attribute__((ext_vector_type(2)));
typedef float f32x4 __attribute__((ext_vector_type(4)));
typedef float f32x16 __attribute__((ext_vector_type(16)));
typedef short bf16x8 __attribute__((ext_vector_type(8)));
typedef short s16x4 __attribute__((ext_vector_type(4)));
#define LDS_WAIT() asm volatile("s_waitcnt lgkmcnt(0)" ::: "memory")
__device__ __forceinline__ unsigned f2bf(float f) { unsigned u = __builtin_bit_cast(unsigned, f); return (u + 0x7fffu + ((u >> 16) & 1u)) >> 16; }
__device__ __forceinline__ unsigned pk2(float lo, float hi) { return pg8::cvt_pk_bf16(lo, hi); }
__device__ __forceinline__ float bf_lo(unsigned w) { return __builtin_bit_cast(float, w << 16); }
__device__ __forceinline__ float bf_hi(unsigned w) { return __builtin_bit_cast(float, w & 0xffff0000u); }
__device__ __forceinline__ float wave_sum(float v) {
#pragma unroll
    for (int o = 1; o < 64; o <<= 1) v += __shfl_xor(v, o);
    return v;
}
#define XB_TMO      128
#define XB_XCNT(j)  (256  + 64 * (j))
#define XB_XSUB(j)  (1280 + 64 * (j))
#define XB_XGEN(j)  (2304 + 64 * (j))
#define XB_TOP      3328
#define XB_TOPGEN   3392
#define XCD_BAR_WORDS 3456
#define XB_SPIN_CAP (1u << 18)

__device__ __forceinline__ unsigned xb_ld(unsigned* p)              { return __hip_atomic_load(p, __ATOMIC_RELAXED, __HIP_MEMORY_SCOPE_AGENT); }
__device__ __forceinline__ unsigned xb_add(unsigned* p, unsigned v) { return __hip_atomic_fetch_add(p, v, __ATOMIC_RELAXED, __HIP_MEMORY_SCOPE_AGENT); }
__device__ __forceinline__ unsigned xb_xcc_id() { return (unsigned)__builtin_amdgcn_s_getreg((3 << 11) | 20) & 0xFu; }
#define XB_SPIN(cond, bar) do { unsigned _sp = 0; while (cond) { __builtin_amdgcn_s_sleep(1); \
    if ((++_sp & 255u) == 0u) { if (xb_ld(&(bar)[XB_TMO])) break; if (_sp > XB_SPIN_CAP) { atomicAdd(&(bar)[XB_TMO], 1u); break; } } } } while (0)

struct XcdBarrier {
    unsigned* bar; unsigned x;
    volatile LAS unsigned* st;
};

__device__ __forceinline__ XcdBarrier xcd_barrier_post(unsigned* bar, volatile LAS unsigned* st, bool is_t0  ) {
    XcdBarrier b; b.bar = bar; b.x = xb_xcc_id(); b.st = st;
    if (is_t0) (void)xb_add(&bar[XB_XCNT(b.x)], 1u);
    return b;
}
__device__ __forceinline__ void xcd_barrier_complete(unsigned* bar, unsigned x, unsigned& nloc, unsigned& nx) {
    const unsigned G = gridDim.x * gridDim.y * gridDim.z;
    unsigned sum, cnt, mine, sp = 0u;
    for (;;) {
        sum = 0u; cnt = 0u; mine = 0u;
#pragma unroll
        for (unsigned j = 0; j < 16; ++j) { const unsigned c = xb_ld(&bar[XB_XCNT(j)]); sum += c; cnt += (c > 0u) ? 1u : 0u; mine = (j == x) ? c : mine; }
        if (sum == G) break;
        __builtin_amdgcn_s_sleep(1);
        if ((++sp & 255u) == 0u) { if (xb_ld(&bar[XB_TMO])) break; if (sp > XB_SPIN_CAP) { atomicAdd(&bar[XB_TMO], 1u); break; } }
    }
    nloc = mine > 0u ? mine : 1u; nx = cnt > 0u ? cnt : 1u;
}

__device__ __forceinline__ void xcd_barrier(const XcdBarrier& b, bool is_t0) {
    asm volatile("s_waitcnt vmcnt(0)" ::: "memory");
    __syncthreads();
    if (is_t0) {
        unsigned* bar = b.bar;
        __builtin_amdgcn_s_waitcnt(0);
        unsigned nloc = b.st[0], nx = b.st[1];
        if (nloc == 0u) { xcd_barrier_complete(bar, b.x, nloc, nx); b.st[0] = nloc; b.st[1] = nx; }
        const unsigned old = xb_add(&bar[XB_XSUB(b.x)], 1u);
        const unsigned gen = old / nloc;
        if (old + 1u == (gen + 1u) * nloc) {
            __builtin_amdgcn_fence(__ATOMIC_RELEASE, "agent");
            asm volatile("s_waitcnt vmcnt(0)" ::: "memory");
            const unsigned og = xb_add(&bar[XB_TOP], 1u);
            const unsigned tg = og / nx;
            if (og + 1u == (tg + 1u) * nx) xb_add(&bar[XB_TOPGEN], 1u);
            else XB_SPIN(xb_ld(&bar[XB_TOPGEN]) == tg, bar);
            __builtin_amdgcn_fence(__ATOMIC_ACQUIRE, "agent");
            xb_add(&bar[XB_XGEN(b.x)], 1u);
            asm volatile("s_waitcnt vmcnt(0)" ::: "memory");
        } else {
            XB_SPIN(xb_ld(&bar[XB_XGEN(b.x)]) == gen, bar);
            __builtin_amdgcn_fence(__ATOMIC_ACQUIRE, "agent");
            asm volatile("s_waitcnt vmcnt(0)" ::: "memory");
        }
    }
    __syncthreads();
}
struct Args { const float* in[17]; float* out; unsigned char* ws; int ph_lo, ph_hi; float l2g[16]; float invf[128]; float lam_init, one_m_lam; };

__device__ __forceinline__ void transpose_item(const float* W, int K, int N, bf16* WT, int dst_row0, int dst_row1, const float* gain, int gmask, float gscale, LAS float* scr, int k0, int n0, int lane) {
    float v[64];
#pragma unroll
    for (int i = 0; i < 64; ++i) v[i] = __builtin_nontemporal_load(W + (size_t)(k0 + i) * N + n0 + lane);
#pragma unroll
    for (int i = 0; i < 64; ++i) scr[i * 65 + lane] = v[i];
    LDS_WAIT(); asm volatile("" ::: "memory");
    const int c = lane & 7;
    float g[8];
#pragma unroll
    for (int e = 0; e < 8; ++e) g[e] = gain ? gain[(k0 + 8 * c + e) & gmask] * gscale : 1.0f;
#pragma unroll
    for (int j = 0; j < 8; ++j) { const int n = (lane >> 3) + 8 * j; const LAS float* s = scr + (8 * c) * 65 + n;
        v4u o; o.x = pk2(s[0 * 65] * g[0], s[1 * 65] * g[1]); o.y = pk2(s[2 * 65] * g[2], s[3 * 65] * g[3]); o.z = pk2(s[4 * 65] * g[4], s[5 * 65] * g[5]); o.w = pk2(s[6 * 65] * g[6], s[7 * 65] * g[7]);
        const int dr = (n < 32 ? dst_row0 : dst_row1 - 32) + n;
        if (MK_BTILED) *(v4u*)(WT + (((size_t)(dr >> 8) * (K >> 6) + (k0 >> 6)) * 256 + (dr & 255)) * 64 + 8 * c) = o;
        else *(v4u*)(WT + (size_t)dr * K + k0 + 8 * c) = o; }
    LDS_WAIT(); asm volatile("" ::: "memory");
}
__device__ __forceinline__ int transpose_dst(int n0, int row_off, int mode) {
    if (mode == 1) { const int sel = n0 >= FF ? 1 : 0, j = n0 - sel * FF; return 256 * (j >> 7) + 128 * sel + (j & 127); }
    return row_off + n0;
}
__device__ __forceinline__ void transpose_job(const float* W, int K, int N, bf16* WT, int row_off, int mode, const float* gain, int gmask, float gscale, LAS float* scr, int gw, int NGW, int lane) {
    const int nblk = N / 64, nitems = (K / 64) * nblk;
    for (int it = gw; it < nitems; it += NGW) { const int kb = it / nblk, nb = it - kb * nblk, n0 = 64 * nb;
        transpose_item(W, K, N, WT, transpose_dst(n0, row_off, mode), transpose_dst(n0 + 32, row_off, mode), gain, gmask, gscale, scr, 64 * kb, n0, lane); }
}
__device__ __forceinline__ void rms_row_to_bf16(const float* xrow, bf16* orow, float* rsp, int lane) {
    const f32x4* xr = (const f32x4*)xrow + lane;
    f32x4 v[16]; float s = 0.f;
#pragma unroll
    for (int j = 0; j < 16; ++j) { v[j] = xr[64 * j]; s += (v[j].x * v[j].x + v[j].y * v[j].y) + (v[j].z * v[j].z + v[j].w * v[j].w); }
    const float rstd = 1.0f / sqrtf(wave_sum(s) * (1.0f / D) + 1e-6f);
    v2u* o8 = (v2u*)orow + lane;
#pragma unroll
    for (int j = 0; j < 16; ++j) { v2u w; w.x = pk2(v[j].x * rstd, v[j].y * rstd); w.y = pk2(v[j].z * rstd, v[j].w * rstd); o8[64 * j] = w; }
    if (lane == 0) *rsp = rstd;
}
template <int MODE> __device__ __forceinline__ void norm_res_rows(const bf16* Yb, const float* PSb, const float* xin, bf16* HBb, const float* gpost, float* RSb, float* outb, int gw, int NGW, int lane) {
    f32x4 g[16];
#pragma unroll
    for (int j = 0; j < 16; ++j) g[j] = ((const f32x4*)gpost + lane)[64 * j];
    for (int m = gw; m < M; m += NGW) {
        const float rstd = 1.0f / sqrtf(wave_sum(PSb[(size_t)m * 64 + lane]) * (1.0f / D) + 1e-6f);
        const v2u* yr = (const v2u*)(Yb + (size_t)m * D) + lane; v2u* hr = (v2u*)(HBb + (size_t)m * D) + lane;
        const float hsc = MODE == 0 ? 1.0f / RSb[m] : 1.0f;
        f32x4 v[16]; float s = 0.f;
#pragma unroll
        for (int j = 0; j < 16; ++j) { const v2u y = yr[64 * j]; f32x4 h;
            { const v2u hh = hr[64 * j]; h.x = bf_lo(hh.x) * hsc; h.y = bf_hi(hh.x) * hsc; h.z = bf_lo(hh.y) * hsc; h.w = bf_hi(hh.y) * hsc; }
            h.x += bf_lo(y.x) * rstd * g[j].x; h.y += bf_hi(y.x) * rstd * g[j].y; h.z += bf_lo(y.y) * rstd * g[j].z; h.w += bf_hi(y.y) * rstd * g[j].w;
            v[j] = h; s += (h.x * h.x + h.y * h.y) + (h.z * h.z + h.w * h.w); }
        if (MODE == 2) {
#pragma unroll
            for (int j = 0; j < 16; ++j) ((f32x4*)(outb + (size_t)m * D) + lane)[64 * j] = v[j];
        } else {
#pragma unroll
            for (int j = 0; j < 16; ++j) { v2u w; w.x = pk2(v[j].x, v[j].y); w.y = pk2(v[j].z, v[j].w); hr[64 * j] = w; }
            const float r2 = 1.0f / sqrtf(wave_sum(s) * (1.0f / D) + 1e-6f); if (lane == 0) RSb[m] = r2; }
    }
}
__device__ __forceinline__ s16x4 tr4(LAS unsigned char* p) { return __builtin_amdgcn_ds_read_tr16_b64_v4i16((LAS s16x4*)p); }
__device__ __forceinline__ bf16x8 cat8(s16x4 a, s16x4 b) { return (bf16x8){a[0], a[1], a[2], a[3], b[0], b[1], b[2], b[3]}; }
constexpr int R12_KS = 136, R12_VS = 72, R12_KB = 128 * R12_KS * 2, R12_VB = 128 * R12_VS * 2, R12_BUF = R12_KB + R12_VB;
static_assert(2 * R12_BUF + 2 * 16384 <= MISC_OFF, "state-phase LDS map");
__device__ __forceinline__ void ret_state_phase(LAS unsigned char* lds, const bf16* Kg, const bf16* Vg, bf16* ST, const float (&l2gtab)[16], int G, int blk, int tid) {
    const int wid = __builtin_amdgcn_readfirstlane(tid >> 6), lane = tid & 63, wk = wid & 3, wv = wid >> 2, l31 = lane & 31, hh = lane >> 5;
    const int q = (lane & 15) >> 2, p = lane & 3, b16 = (lane >> 4) & 1;
    const int ka_off = ((8 * hh + q) * R12_KS + 32 * wk + 16 * b16 + 4 * p) * 2, vb_off = ((8 * hh + q) * R12_VS + 32 * wv + 16 * b16 + 4 * p) * 2;
    for (int u0 = blk; u0 < 256; u0 += G) {
        const int u = (((u0 & 7) * 4 + ((u0 >> 3) >> 3)) << 3) | ((u0 >> 3) & 7);
        const int bh = u >> 3, b = bh >> 4, h = bh & 15, vq = (u >> 1) & 3, kh = u & 1;
        const float l2g = l2gtab[h], cd = __builtin_amdgcn_exp2f(l2g * 128.0f);
        const bf16* Kp = Kg + ((size_t)b * 8192) * 4096 + h * 256 + kh * 128 + (size_t)(tid >> 4) * 4096 + (tid & 15) * 8;
        const bf16* Vp = Vg + ((size_t)b * 8192) * 4096 + h * 256 + vq * 64 + (size_t)(tid >> 3) * 4096 + (tid & 7) * 8;
        bf16* Sb = ST + ((size_t)bh * 64) * 65536 + (size_t)(vq * 64) * 256 + kh * 128;
        v4u krA[4], vrA[2], krB[4], vrB[2];
#define R12_LOAD(kr, vr, cc) do { _Pragma("unroll") for (int j = 0; j < 4; ++j) kr[j] = *(const v4u*)(Kp + (size_t)((cc) * 128 + 32 * j) * 4096); \
        _Pragma("unroll") for (int j = 0; j < 2; ++j) vr[j] = *(const v4u*)(Vp + (size_t)((cc) * 128 + 64 * j) * 4096); } while (0)
        R12_LOAD(krA, vrA, 0); R12_LOAD(krB, vrB, 1);
        f32x16 acc;
#pragma unroll
        for (int r = 0; r < 16; ++r) acc[r] = 0.f;
#define R12_STEP(kr, vr, c) do { \
            LAS unsigned char* Kb = lds + ((c) & 1) * R12_BUF; LAS unsigned char* Vb = Kb + R12_KB; \
            _Pragma("unroll") for (int j = 0; j < 4; ++j) *(LAS v4u*)(Kb + (((tid >> 4) + 32 * j) * R12_KS + (tid & 15) * 8) * 2) = kr[j]; \
            _Pragma("unroll") for (int j = 0; j < 2; ++j) { const int row = (tid >> 3) + 64 * j; const float dec = __builtin_amdgcn_exp2f(l2g * (float)(127 - row)); const v4u x = vr[j]; v4u w; \
                w.x = pk2(bf_lo(x.x) * dec, bf_hi(x.x) * dec); w.y = pk2(bf_lo(x.y) * dec, bf_hi(x.y) * dec); w.z = pk2(bf_lo(x.z) * dec, bf_hi(x.z) * dec); w.w = pk2(bf_lo(x.w) * dec, bf_hi(x.w) * dec); \
                *(LAS v4u*)(Vb + (row * R12_VS + (tid & 7) * 8) * 2) = w; } \
            if ((c) + 2 < 64) R12_LOAD(kr, vr, (c) + 2); \
              \
            { LAS unsigned char* Tb = lds + 2 * R12_BUF + ((c) & 1) * 16384; const int vl = 32 * wv + l31; \
              _Pragma("unroll") for (int g = 0; g < 4; ++g) { const int k0 = 32 * wk + 8 * g + 4 * hh; v2u w; w.x = pk2(acc[4 * g], acc[4 * g + 1]); w.y = pk2(acc[4 * g + 2], acc[4 * g + 3]); \
                  *(LAS v2u*)(Tb + vl * 256 + (((k0 >> 3) ^ (vl & 15)) << 4) + ((k0 & 4) << 1)) = w; } \
              __syncthreads(); \
              _Pragma("unroll") for (int j = 0; j < 2; ++j) { const int ci = tid + 512 * j, row = ci >> 4, ch = ci & 15; const v4u w = *(const LAS v4u*)(Tb + row * 256 + ((ch ^ (row & 15)) << 4)); \
                  *(v4u*)(Sb + (size_t)(c) * 65536 + (size_t)row * 256 + ch * 8) = w; } } \
            _Pragma("unroll") for (int r = 0; r < 16; ++r) acc[r] *= cd; \
            _Pragma("unroll") for (int ts = 0; ts < 8; ++ts) { \
                const bf16x8 a = cat8(tr4(Kb + ka_off + (16 * ts) * R12_KS * 2), tr4(Kb + ka_off + (16 * ts + 4) * R12_KS * 2)); \
                const bf16x8 bb = cat8(tr4(Vb + vb_off + (16 * ts) * R12_VS * 2), tr4(Vb + vb_off + (16 * ts + 4) * R12_VS * 2)); \
                acc = __builtin_amdgcn_mfma_f32_32x32x16_bf16(a, bb, acc, 0, 0, 0); } } while (0)
        for (int c = 0; c < 64; c += 2) { R12_STEP(krA, vrA, c); R12_STEP(krB, vrB, c + 1); }
#undef R12_STEP
#undef R12_LOAD
        __syncthreads();
    }
}
constexpr int R3_KS = 264, R3_SS = 136, R3_SOFF = 0, R3_STOFF = 8 * 16 * R3_SS * 2, R3_B1 = R3_STOFF + 64 * R3_KS * 2;
static_assert(R3_B1 >= 128 * R3_KS * 2 && R3_B1 + 128 * R3_KS * 2 <= MISC_OFF, "retention LDS map");
__device__ __forceinline__ void ret_out_phase(LAS unsigned char* lds, const bf16* Qg, const bf16* Kg, const bf16* Vg, const bf16* Gg, const bf16* ST, bf16* RA, const float (&l2gtab)[16], int G, int blk, int tid) {
    const int wid = __builtin_amdgcn_readfirstlane(tid >> 6);
    LAS unsigned char* B0 = lds; LAS unsigned char* SB = lds + R3_SOFF + wid * (16 * R3_SS * 2); LAS unsigned char* STB = lds + R3_STOFF; LAS unsigned char* B1 = lds + R3_B1;
    for (int u = blk; u < 2048; u += G) {
        int lane = tid & 63; asm volatile("" : "+v"(lane));
        const int fr = lane & 15, fq = lane >> 4, q = (lane & 15) >> 2, p = lane & 3, lrow = 2 * wid + (lane >> 5), lch = lane & 31;
        const int bh = u >> 6, c = u & 63, b = bh >> 4, h = bh & 15;
        const float l2g = l2gtab[h];
        const size_t row0 = (size_t)b * 8192 + (size_t)c * 128;
        const bf16* Qp = Qg + row0 * 4096 + h * 256; const bf16* Kp = Kg + row0 * 4096 + h * 256; const bf16* Vp = Vg + row0 * 4096 + h * 256;
        const bf16* STp = ST + ((size_t)bh * 64 + c) * 65536;
        bf16x8 qf[8];
        { v4u tk[8], tv[8];
#pragma unroll
          for (int j = 0; j < 8; ++j) tk[j] = *(const v4u*)(Kp + (size_t)(lrow + 16 * j) * 4096 + lch * 8);
#pragma unroll
          for (int j = 0; j < 8; ++j) tv[j] = *(const v4u*)(Vp + (size_t)(lrow + 16 * j) * 4096 + lch * 8);
#pragma unroll
          for (int ks = 0; ks < 8; ++ks) qf[ks] = *(const bf16x8*)(Qp + (size_t)(16 * wid + fr) * 4096 + 32 * ks + 8 * fq);
#pragma unroll
          for (int j = 0; j < 8; ++j) *(LAS v4u*)(B0 + ((lrow + 16 * j) * R3_KS + lch * 8) * 2) = tk[j];
#pragma unroll
          for (int j = 0; j < 8; ++j) *(LAS v4u*)(B1 + ((lrow + 16 * j) * R3_KS + lch * 8) * 2) = tv[j]; }
        __syncthreads();
        f32x4 s[8];
#pragma unroll
        for (int j = 0; j < 8; ++j) { s[j] = (f32x4){0.f, 0.f, 0.f, 0.f};
#pragma unroll
            for (int ks = 0; ks < 8; ++ks) { const bf16x8 kf = *(const LAS bf16x8*)(B0 + ((16 * j + fr) * R3_KS + 32 * ks + 8 * fq) * 2); s[j] = __builtin_amdgcn_mfma_f32_16x16x32_bf16(qf[ks], kf, s[j], 0, 0, 0); } }
        v4u stA[4], stB[4];
#define R3_LDST(st, qq) do { _Pragma("unroll") for (int j = 0; j < 4; ++j) st[j] = *(const v4u*)(STp + (size_t)((qq) * 64 + lrow + 16 * j) * 256 + lch * 8); } while (0)
#define R3_WRST(st) do { _Pragma("unroll") for (int j = 0; j < 4; ++j) *(LAS v4u*)(STB + ((lrow + 16 * j) * R3_KS + lch * 8) * 2) = st[j]; } while (0)
        R3_LDST(stA, 0); R3_LDST(stB, 1);
        __syncthreads();
        { int d0 = 16 * wid + 4 * fq - fr; asm volatile("" : "+v"(d0));
          const float eb = l2g * (float)d0;
#pragma unroll
          for (int j = 0; j < 8; ++j)
#pragma unroll
            for (int r = 0; r < 4; ++r) {
                const float v = s[j][r] * __builtin_amdgcn_exp2f(fmaf(l2g, (float)(r - 16 * j), eb)); unsigned sg; asm volatile("v_ashrrev_i32 %0, 31, %1" : "=v"(sg) : "v"(d0 + (r - 16 * j)));
                *(LAS unsigned short*)(SB + ((4 * fq + r) * R3_SS + 16 * j + fr) * 2) = (unsigned short)(f2bf(v) & ~sg); } }
        R3_WRST(stA);
        f32x4 o[16];
#pragma unroll
        for (int nt = 0; nt < 16; ++nt) o[nt] = (f32x4){0.f, 0.f, 0.f, 0.f};
#pragma unroll
        for (int vq = 0; vq < 4; ++vq) {
            if (vq == 0) R3_LDST(stA, 2); if (vq == 1) R3_LDST(stB, 3);
            __syncthreads();
#pragma unroll
            for (int n4 = 0; n4 < 4; ++n4)
#pragma unroll
                for (int ks = 0; ks < 8; ++ks) { const bf16x8 sf = *(const LAS bf16x8*)(STB + ((16 * n4 + fr) * R3_KS + 32 * ks + 8 * fq) * 2); o[4 * vq + n4] = __builtin_amdgcn_mfma_f32_16x16x32_bf16(qf[ks], sf, o[4 * vq + n4], 0, 0, 0); }
            if (vq < 3) { __syncthreads(); if (vq == 0) R3_WRST(stB); if (vq == 1) R3_WRST(stA); if (vq == 2) R3_WRST(stB); }
        }
#undef R3_LDST
#undef R3_WRST
        v4u g8[8];
#pragma unroll
        for (int j = 0; j < 8; ++j) g8[j] = *(const v4u*)(Gg + (row0 + 16 * wid + 2 * j + (lane >> 5)) * 4096 + h * 256 + (lane & 31) * 8);
#pragma unroll
        for (int r = 0; r < 4; ++r) { const float dq = __builtin_amdgcn_exp2f(l2g * (float)(16 * wid + 4 * fq + r + 1));
#pragma unroll
            for (int nt = 0; nt < 16; ++nt) o[nt][r] *= dq; }
#pragma unroll
        for (int ts = 0; ts < 4; ++ts) {
            { const bf16x8 sf = *(const LAS bf16x8*)(SB + (fr * R3_SS + 32 * ts + 8 * fq) * 2);
#pragma unroll
                for (int nt = 0; nt < 16; ++nt) { LAS unsigned char* vp = B1 + ((32 * ts + 8 * fq + q) * R3_KS + 16 * nt + 4 * p) * 2;
                    const bf16x8 vf = cat8(tr4(vp), tr4(vp + 4 * R3_KS * 2)); o[nt] = __builtin_amdgcn_mfma_f32_16x16x32_bf16(sf, vf, o[nt], 0, 0, 0); } } }
        __syncthreads();
        LAS unsigned char* EST = B1 + wid * (16 * R3_KS * 2);
#pragma unroll
        for (int j = 0; j < 8; ++j) *(LAS v4u*)(EST + ((2 * j + (lane >> 5)) * R3_KS + (lane & 31) * 8) * 2) = g8[j];
        asm volatile("" ::: "memory");
#pragma unroll
        for (int r = 0; r < 4; ++r) { float sm = 0.f;
#pragma unroll
            for (int nt = 0; nt < 16; ++nt) sm += o[nt][r];
            sm += __shfl_xor(sm, 1); sm += __shfl_xor(sm, 2); sm += __shfl_xor(sm, 4); sm += __shfl_xor(sm, 8);
            const float mu = sm * (1.0f / 256.0f); float vs = 0.f;
#pragma unroll
            for (int nt = 0; nt < 16; ++nt) { const float d = o[nt][r] - mu; vs += d * d; }
            vs += __shfl_xor(vs, 1); vs += __shfl_xor(vs, 2); vs += __shfl_xor(vs, 4); vs += __shfl_xor(vs, 8);
            const float rstd = 1.0f / sqrtf(vs * (1.0f / 256.0f) + 1e-5f);
            LAS unsigned short* gp = (LAS unsigned short*)(EST + ((4 * fq + r) * R3_KS + fr) * 2);
#pragma unroll
            for (int nt = 0; nt < 16; ++nt) { const float g = __builtin_bit_cast(float, (unsigned)gp[16 * nt] << 16); gp[16 * nt] = (unsigned short)f2bf((o[nt][r] - mu) * rstd * g); } }
        asm volatile("" ::: "memory");
#pragma unroll
        for (int j = 0; j < 8; ++j) { const v4u w = *(const LAS v4u*)(EST + ((2 * j + (lane >> 5)) * R3_KS + (lane & 31) * 8) * 2);
            *(v4u*)(RA + (row0 + 16 * wid + 2 * j + (lane >> 5)) * 4096 + h * 256 + (lane & 31) * 8) = w; }
        __syncthreads();
    }
}
#ifndef MK_ATT16
#define MK_ATT16 1
#endif
#if MK_ATT16
#define MK_ATT_BLOCK att::attn16_block
#else
#define MK_ATT_BLOCK att::attn2_block
#endif
__device__ __forceinline__ att::Ref2 att_ref2(int bh, int i, int qb, const bf16* QH, const bf16* KH, const bf16* VH, float* X, bf16* RA, float lam) {
    const int hm = bh * 2 + i, b = bh >> 4, h = bh & 15;
    att::Ref2 r;
    r.Q = QH + ((size_t)hm * 8192 + (size_t)qb * 256) * 128; r.K = KH + (size_t)hm * 8192 * 128; r.V0 = VH + (size_t)(bh * 2) * 8192 * 128; r.V1 = VH + (size_t)(bh * 2 + 1) * 8192 * 128;
    r.X = X; r.RA = RA + ((size_t)b * 8192 + (size_t)qb * 256) * 4096 + h * 256; r.lam = lam; r.P0 = qb * 256;
    return r;
}
__device__ __forceinline__ void attn_phase(char* lds, const bf16* QH, const bf16* KH, const bf16* VH, float* XS, bf16* RA, const float* lamp, float lam_init, int G, int blk, int wave_id) {
    const int lane = mk_lane();
    float a = lamp[lane] * lamp[128 + lane] + lamp[64 + lane] * lamp[192 + lane], c = lamp[256 + lane] * lamp[384 + lane] + lamp[320 + lane] * lamp[448 + lane];
    const float lam = __builtin_bit_cast(float, __builtin_amdgcn_readfirstlane(__builtin_bit_cast(int, __expf(wave_sum(a)) - __expf(wave_sum(c)) + lam_init)));
    float* X = XS + (size_t)blk * (8 * 32 * 64 * 4);
    for (int L = blk; L < 512; L += G) {
        const int xcd = L & 7, k = L >> 3, bh = xcd * 4 + (k >> 4), x = k & 15;
        { const att::Ref2 cur = att_ref2(bh, 0, 31 - x, QH, KH, VH, X, RA, lam); MK_ATT_BLOCK<0>(cur, lds, wave_id); }
        { const att::Ref2 cur = att_ref2(bh, 0, x, QH, KH, VH, X + 8 * 16 * 64 * 4, RA, lam); MK_ATT_BLOCK<0>(cur, lds, wave_id); }
        { const att::Ref2 cur = att_ref2(bh, 1, 31 - x, QH, KH, VH, X, RA, lam); MK_ATT_BLOCK<1>(cur, lds, wave_id); }
        { const att::Ref2 cur = att_ref2(bh, 1, x, QH, KH, VH, X + 8 * 16 * 64 * 4, RA, lam); MK_ATT_BLOCK<1>(cur, lds, wave_id); }
    }
}
extern __shared__ __attribute__((aligned(16))) unsigned char lds_raw[];
struct Ctx { LAS unsigned char* lds; unsigned char* ws; int wave, G, blk, gw, NGW; };
template <int P> __device__ __forceinline__ void run_phase(const Ctx& c, const Args& a) {
    const int tid = c.wave * 64 + mk_lane();
    unsigned char* ws = c.ws; const int G = c.G, blk = c.blk, gw = c.gw, NGW = c.NGW, lane = tid & 63; LAS unsigned char* lds = c.lds;
    bf16* const W_in = (bf16*)(ws + WS_WIN); bf16* const W_ro = (bf16*)(ws + WS_WRO); bf16* const W_kvq = (bf16*)(ws + WS_WKVQ); bf16* const W_do = (bf16*)(ws + WS_WDO);
    bf16* const W_gu = (bf16*)(ws + WS_WGU); bf16* const W_dn = (bf16*)(ws + WS_WDN);
    bf16* const XN = (bf16*)(ws + WS_XN); bf16* const RA = (bf16*)(ws + WS_RA); bf16* const Y = (bf16*)(ws + WS_Y); float* const PS = (float*)(ws + WS_PS);
    bf16* const QKVG = (bf16*)(ws + WS_A); bf16* const KVQ = (bf16*)(ws + WS_A);
    bf16* const STT = (bf16*)(ws + WS_B); bf16* const HB = (bf16*)(ws + WS_B); float* const AO = (float*)(ws + WS_B);
    constexpr size_t TSZ = (size_t)M * 4096, HSZ = (size_t)64 * 8192 * 128;
    float* const RS = (float*)(ws + WS_RS);
    if constexpr (P == 0) {
        LAS float* scr = (LAS float*)(lds + c.wave * 16896);
        transpose_job(a.in[3], D, 4 * D, W_in, 0, 0, a.in[1], 0x7fffffff, 1.0f, scr, gw, NGW, lane);
        transpose_job(a.in[4], D, D, W_ro, 0, 0, nullptr, 0, 1.0f, scr, gw, NGW, lane);
        transpose_job(a.in[6], D, 2 * D, W_kvq, 0, 0, a.in[5], 0x7fffffff, 1.0f, scr, gw, NGW, lane);
        transpose_job(a.in[9], D, D, W_kvq, 2 * D, 0, a.in[7], 0x7fffffff, 1.4426950408889634f * att::SCALE, scr, gw, NGW, lane);
        transpose_job(a.in[12], D, D, W_do, 0, 0, a.in[11], 255, a.one_m_lam, scr, gw, NGW, lane);
        for (int l = 0; l < 2; ++l) {
            transpose_job(a.in[15] + (size_t)l * D * 2 * FF, D, 2 * FF, W_gu + (size_t)l * 2 * FF * D, 0, 1, a.in[13] + l * D, 0x7fffffff, 1.0f, scr, gw, NGW, lane);
            transpose_job(a.in[16] + (size_t)l * FF * D, FF, D, W_dn + (size_t)l * D * FF, 0, 0, nullptr, 0, 1.0f, scr, gw, NGW, lane); }
        for (int m = gw; m < M; m += NGW) rms_row_to_bf16(a.in[0] + (size_t)m * D, XN + (size_t)m * D, RS + m, lane);
    }
    if constexpr (P == 1) {
        pg8::Gemm g{XN, W_in, M, 4 * D, D}; pg8::EpiQKVG E{QKVG};
#if MK_NSTAT
        pg8::NStatOrder S; S.init(M, 4 * D, G, blk); pg8::gemm_phase<pg8::EpiQKVG, pg8::NStatOrder, MK_ALIGN, MK_SP2>(lds, g, S, E, c.wave); }
#else
        pg8::StaticOrder S; S.init(M, 4 * D, G, blk); pg8::gemm_phase<pg8::EpiQKVG, pg8::StaticOrder, MK_ALIGN, MK_SP2>(lds, g, S, E, c.wave); }
#endif
    if constexpr (P == 2) ret_state_phase(lds, QKVG + TSZ, QKVG + 2 * TSZ, STT, a.l2g, G, blk, tid);
    if constexpr (P == 3) ret_out_phase(lds, QKVG, QKVG + TSZ, QKVG + 2 * TSZ, QKVG + 3 * TSZ, STT, RA, a.l2g, G, blk, tid);
    if constexpr (P == 4 || P == 12) { pg8::Gemm g{RA, P == 4 ? W_ro : W_do, M, D, D}; pg8::StaticOrder S; S.init(M, D, G, blk); pg8::EpiYSS E{Y, PS};
        pg8::gemm_phase<pg8::EpiYSS, pg8::StaticOrder, MK_ALIGN, MK_SP2>(lds, g, S, E, c.wave); }
    if constexpr (P == 5)  norm_res_rows<0>(Y, PS, a.in[0], XN, a.in[2], RS, nullptr, gw, NGW, lane);
    if constexpr (P == 8)  norm_res_rows<1>(Y, PS, nullptr, XN, a.in[14], RS, nullptr, gw, NGW, lane);
    if constexpr (P == 13) norm_res_rows<1>(Y, PS, nullptr, XN, a.in[8], RS, nullptr, gw, NGW, lane);
    if constexpr (P == 16) norm_res_rows<2>(Y, PS, nullptr, XN, a.in[14] + D, nullptr, a.out, gw, NGW, lane);
    constexpr bool L1 = (P == 14 || P == 15 || P == 114); constexpr int MH = MK_FFN_SPLIT ? M / 2 : M, PMH = M / 512;
    if constexpr (P == 6 || P == 14 || ((P == 7 || P == 15) && MK_FFN_SPLIT)) {
        if constexpr (P == 7 || P == 15) { pg8::Gemm g{HB, W_dn + (L1 ? (size_t)D * FF : 0), M, D, FF}; pg8::StaticOrder S; S.init(MH, D, G, blk, 0); pg8::EpiYSS E{Y, PS};
            pg8::gemm_phase<pg8::EpiYSS, pg8::StaticOrder, MK_ALIGN, MK_SP2, MK_HTILED != 0>(lds, g, S, E, c.wave); }
        pg8::Gemm g{XN, W_gu + (L1 ? (size_t)2 * FF * D : 0), M, 2 * FF, D}; pg8::StaticOrder S; S.init(MH, 2 * FF, G, blk, (P == 7 || P == 15) ? PMH : 0); pg8::EpiSwiGLU E{HB, RS};
        pg8::gemm_phase<pg8::EpiSwiGLU, pg8::StaticOrder, MK_ALIGN, MK_SP2>(lds, g, S, E, c.wave); }
    if constexpr (((P == 7 || P == 15) && !MK_FFN_SPLIT) || P == 106 || P == 114) { pg8::Gemm g{HB, W_dn + (L1 ? (size_t)D * FF : 0), M, D, FF}; pg8::StaticOrder S; S.init(MH, D, G, blk, MK_FFN_SPLIT ? PMH : 0); pg8::EpiYSS E{Y, PS};
        pg8::gemm_phase<pg8::EpiYSS, pg8::StaticOrder, MK_ALIGN, MK_SP2, MK_HTILED != 0>(lds, g, S, E, c.wave); }
    if constexpr (P == 9) { pg8::Gemm g{XN, W_kvq, M, 3 * D, D}; pg8::StaticOrder S; S.init(M, 3 * D, G, blk); pg8::EpiKVQ E{KVQ, RS};
        pg8::gemm_phase<pg8::EpiKVQ, pg8::StaticOrder, MK_ALIGN, MK_SP2>(lds, g, S, E, c.wave); }
    if constexpr (P == 10) attn_phase((char*)lds_raw, KVQ + 2 * HSZ, KVQ, KVQ + HSZ, AO, RA, a.in[10], a.lam_init, G, blk, c.wave);
}
__global__ void __launch_bounds__(NWAVES * 64, 2) mk_fwd(Args a) {
    Ctx c; c.lds = (LAS unsigned char*)lds_raw; c.ws = a.ws;
    volatile LAS unsigned* MISC = (volatile LAS unsigned*)(c.lds + MISC_OFF);
    c.wave = __builtin_amdgcn_readfirstlane((int)threadIdx.x >> 6); c.G = gridDim.x; c.blk = blockIdx.x;
    c.gw = c.blk * NWAVES + c.wave; c.NGW = c.G * NWAVES;
    for (int u = threadIdx.x; u < (LDS_BYTES - MISC_OFF) / 4; u += NWAVES * 64) ((LAS unsigned*)(c.lds + MISC_OFF))[u] = 0u;
    __syncthreads();
    XcdBarrier bar; bar.bar = (unsigned*)(a.ws + WS_CTL) + CW_BAR; bar.x = 0; bar.st = nullptr;
    if (N_LAUNCHES == 1) bar = xcd_barrier_post((unsigned*)(a.ws + WS_CTL) + CW_BAR, MISC + 8, threadIdx.x == 0);
    const int lo = a.ph_lo, hi = a.ph_hi;
#define IN(k) (((MK_PHASE_MASK >> (k)) & 1) && lo <= (k) && (k) < hi)
    static_assert(N_LAUNCHES == 1 || !MK_FFN_SPLIT, "the one-launch-per-phase bring-up build has no barrier inside a launch: build it with MK_FFN_SPLIT 0");
#define RUNX(k, kk) do { if (MK_FFN_SPLIT && IN(k)) { run_phase<kk>(c, a); if (N_LAUNCHES == 1 && IN((k) + 1)) xcd_barrier(bar, c.wave == 0 && mk_lane() == 0); } } while (0)
#define RUN(k) do { if (IN(k)) { run_phase<k>(c, a); if constexpr ((MK_REPEAT_MASK >> (k)) & 1) { if (MK_REPEAT_BARRIER) xcd_barrier(bar, c.wave == 0 && mk_lane() == 0); run_phase<k>(c, a); } } if (N_LAUNCHES == 1 && IN(k) && IN((k) + 1)) { xcd_barrier(bar, c.wave == 0 && mk_lane() == 0); for (int xb_ = 0; xb_ < MK_EXTRA_BARRIERS; ++xb_) xcd_barrier(bar, c.wave == 0 && mk_lane() == 0); } } while (0)
    RUN(0); RUN(1); RUN(2); RUN(3); RUN(4); RUN(5); RUN(6);
    RUN(7); RUNX(7, 106); RUN(8); RUN(9); RUN(10);
    RUN(12); RUN(13); RUN(14); RUN(15); RUNX(15, 114); RUN(16);
#undef IN
#undef RUN
#undef RUNX
}

extern "C" void kernel_launch(void* const* d_in, const int* in_sizes, int n_in, void* d_out, int out_size, void* d_ws, size_t ws_size, hipStream_t stream) {
    static int grid = 0;
    if (grid == 0) {
        if (n_in != 17 || out_size != M * D || ws_size < WS_END) { fprintf(stderr, "kernel_launch: unexpected problem (n_in %d, out %d, ws %zu)\n", n_in, out_size, ws_size); grid = -1; return; }
        int dev = 0, cus = 0;
        if (hipGetDevice(&dev) != hipSuccess || hipDeviceGetAttribute(&cus, hipDeviceAttributeMultiprocessorCount, dev) != hipSuccess) { grid = -1; return; }
        if (hipFuncSetAttribute((const void*)mk_fwd, hipFuncAttributeMaxDynamicSharedMemorySize, LDS_BYTES) != hipSuccess) { fprintf(stderr, "kernel_launch: hipFuncSetAttribute failed\n"); grid = -1; return; }
        int per_cu = 0;
        if (hipOccupancyMaxActiveBlocksPerMultiprocessor(&per_cu, (const void*)mk_fwd, NWAVES * 64, LDS_BYTES) != hipSuccess || per_cu < 1) fprintf(stderr, "kernel_launch: occupancy query says %d\n", per_cu);
        (void)hipGetLastError();
        grid = cus;
    }
    if (grid < 0) return;
    (void)hipMemsetAsync((char*)d_ws + WS_CTL + (size_t)CW_BAR * 4, 0, (size_t)XCD_BAR_WORDS * 4, stream);
    Args a{};
    for (int i = 0; i < 17; ++i) a.in[i] = (const float*)d_in[i];
    a.out = (float*)d_out; a.ws = (unsigned char*)d_ws;
    for (int h = 0; h < 16; ++h) a.l2g[h] = (float)(log1p(-exp2(-5.0 - (double)h)) / log(2.0));
    for (int j = 0; j < 128; ++j) a.invf[j] = (float)(1.0 / pow(10000.0, (double)j / 127.0));
    const double li = 0.8 - 0.6 * exp(-0.3 * 1.0);
    a.lam_init = (float)li; a.one_m_lam = (float)(1.0 - li);
    if (N_LAUNCHES == 1) { a.ph_lo = 0; a.ph_hi = NPH; hipLaunchKernelGGL(mk_fwd, dim3(grid), dim3(NWAVES * 64), LDS_BYTES, stream, a); }
    else for (int p = 0; p < NPH; ++p) { a.ph_lo = p; a.ph_hi = p + 1; hipLaunchKernelGGL(mk_fwd, dim3(grid), dim3(NWAVES * 64), LDS_BYTES, stream, a); }
}
```
